# Optimizing an MI355X kernel written in HIP

```python
import jax, jax.numpy as jnp
from jax import lax
import numpy as np

D_MODEL = 1024
BATCH = 16
SEQ = 2048
DEPTH = 1

PLE_DIM = 256
SB_HEADS = 8
SB_HEAD_DIM = 64
SB_BLOCK = 128
RET_HEADS = 8
RET_QK_DIM = 64
RET_V_DIM = 128
RET_CHUNK = 128
ROPE_BASE = 10000.0
D_FF = 2816
CONV_WIDTH = 3
EPS = 1e-6

SB_W = SB_HEADS * SB_HEAD_DIM
RET_QK_W = RET_HEADS * RET_QK_DIM
RET_V_W = RET_HEADS * RET_V_DIM
IN_SPLITS = (SB_W, SB_W, SB_W, RET_QK_W, RET_QK_W, RET_V_W, RET_V_W, D_MODEL, D_MODEL)
D_IN = SB_W * 3 + RET_QK_W * 2 + RET_V_W * 2 + D_MODEL * 2

kernel_name = "hybrid_stickbreak_retention_convglu_ple"


def rmsnorm(x, gain):
    xf = x.astype(jnp.float32)
    xf = xf * lax.rsqrt(jnp.mean(xf * xf, axis=-1, keepdims=True) + EPS)
    return (xf * gain.astype(jnp.float32)).astype(x.dtype)


def head_rmsnorm(x, gain):
    xf = x.astype(jnp.float32)
    xf = xf * lax.rsqrt(jnp.mean(xf * xf, axis=-1, keepdims=True) + EPS)
    return (xf * gain.astype(jnp.float32)[None, :, None, :]).astype(x.dtype)


def split_cols(y):
    out = []
    off = 0
    for w in IN_SPLITS:
        out.append(y[..., off:off + w])
        off += w
    return out


def to_heads(t, n_heads):
    b, s, _ = t.shape
    return t.reshape(b, s, n_heads, -1).transpose(0, 2, 1, 3)


def from_heads(t):
    b, h, s, d = t.shape
    return t.transpose(0, 2, 1, 3).reshape(b, s, h * d)


def rotary(x):
    s, d = x.shape[2], x.shape[3]
    half = d // 2
    inv = ROPE_BASE ** (-jnp.arange(half, dtype=jnp.float32) * 2.0 / d)
    ang = jnp.arange(s, dtype=jnp.float32)[:, None] * inv[None, :]
    cos, sin = jnp.cos(ang), jnp.sin(ang)
    xf = x.astype(jnp.float32)
    x1, x2 = xf[..., :half], xf[..., half:]
    return jnp.concatenate([x1 * cos - x2 * sin, x1 * sin + x2 * cos], axis=-1).astype(x.dtype)


def stick_breaking_attention(q, k, v):
    s_len, d = q.shape[2], q.shape[3]
    scale = d ** -0.5
    outs = []
    for i in range(s_len // SB_BLOCK):
        t0 = i * SB_BLOCK
        n_keys = t0 + SB_BLOCK
        qb = q[:, :, t0:t0 + SB_BLOCK]
        kk = k[:, :, :n_keys]
        vv = v[:, :, :n_keys]
        z = jnp.einsum('bhtd,bhsd->bhts', qb, kk).astype(jnp.float32) * scale
        qpos = t0 + jnp.arange(SB_BLOCK)[:, None]
        kpos = jnp.arange(n_keys)[None, :]
        causal = kpos < qpos
        log_one_minus = jnp.where(causal, -jax.nn.softplus(z), 0.0)
        suffix = lax.cumsum(log_one_minus, axis=3, reverse=True) - log_one_minus
        log_a = jax.nn.log_sigmoid(z) + suffix
        a = jnp.where(causal, jnp.exp(log_a), 0.0).astype(v.dtype)
        outs.append(jnp.einsum('bhts,bhsd->bhtd', a, vv))
    return jnp.concatenate(outs, axis=2)


def retention_chunkwise(q, k, v):
    b, h, s_len, dk = q.shape
    dv = v.shape[3]
    c = RET_CHUNK
    n_chunks = s_len // c
    log_gamma = jnp.log1p(-jnp.exp2(-5.0 - jnp.arange(h, dtype=jnp.float32)))
    idx = jnp.arange(c, dtype=jnp.float32)
    diff = idx[:, None] - idx[None, :]
    d_local = jnp.where(diff >= 0.0,
                        jnp.exp(jnp.maximum(diff, 0.0)[None] * log_gamma[:, None, None]), 0.0)
    xi = jnp.exp((idx + 1.0)[None, :] * log_gamma[:, None])
    zeta = jnp.exp((c - 1.0 - idx)[None, :] * log_gamma[:, None])
    g_chunk = jnp.exp(c * log_gamma)

    def chunked(t):
        return jnp.moveaxis(t.reshape(b, h, n_chunks, c, t.shape[3]), 2, 0)

    def step(state, inp):
        qc, kc, vc = inp
        inner = jnp.einsum('bhid,bhjd->bhij', qc, kc) * d_local[None]
        y = (jnp.einsum('bhij,bhje->bhie', inner, vc)
             + jnp.einsum('bhid,bhde->bhie', qc, state) * xi[None, :, :, None])
        new_state = (state * g_chunk[None, :, None, None]
                     + jnp.einsum('bhjd,bhje->bhde', kc * zeta[None, :, :, None], vc))
        return new_state, y

    state0 = jnp.zeros((b, h, dk, dv), jnp.float32)
    _, ys = lax.scan(step, state0, (chunked(q), chunked(k), chunked(v)))
    return jnp.moveaxis(ys, 0, 2).reshape(b, h, s_len, dv).astype(v.dtype)


def causal_depthwise_conv(a, w, bias):
    s_len = a.shape[1]
    padded = jnp.pad(a, ((0, 0), (CONV_WIDTH - 1, 0), (0, 0)))
    out = bias
    for j in range(CONV_WIDTH):
        out = out + w[j] * padded[:, j:j + s_len]
    return out


def hybrid_layer(x, p_i, g_mix, w_in, sb_q_gain, sb_k_gain, ret_norm_gain,
                 w_branch_sb, w_branch_ret, w_out, g_ffn, w_up, conv_w, conv_b,
                 w_down, g_ple, w_ple_gate, w_ple_proj):
    h = rmsnorm(x, g_mix)
    q_sb, k_sb, v_sb, q_r, k_r, v_r, g_r, gate_sb, gate_ret = split_cols(h @ w_in)

    q_sb = head_rmsnorm(to_heads(q_sb, SB_HEADS), sb_q_gain)
    k_sb = head_rmsnorm(to_heads(k_sb, SB_HEADS), sb_k_gain)
    y_sb = from_heads(stick_breaking_attention(q_sb, k_sb, to_heads(v_sb, SB_HEADS)))

    q_r = rotary(to_heads(q_r, RET_HEADS))
    k_r = rotary(to_heads(k_r, RET_HEADS)) * (RET_QK_DIM ** -0.5)
    y_r = retention_chunkwise(q_r, k_r, to_heads(v_r, RET_HEADS))
    y_r = from_heads(head_rmsnorm(y_r, ret_norm_gain)) * jax.nn.silu(g_r)

    merged = (jax.nn.sigmoid(gate_sb) * (y_sb @ w_branch_sb)
              + jax.nn.sigmoid(gate_ret) * (y_r @ w_branch_ret))
    x = x + merged @ w_out

    h = rmsnorm(x, g_ffn)
    up = h @ w_up
    a, u = up[..., :D_FF], up[..., D_FF:]
    a = causal_depthwise_conv(a, conv_w, conv_b)
    x = x + (jax.nn.gelu(a) * u) @ w_down

    gate = jax.nn.sigmoid(rmsnorm(x, g_ple) @ w_ple_gate)
    x = x + gate * (p_i @ w_ple_proj)
    return x


def setup_inputs(seed: int = 0) -> dict:
    key = jax.random.key(seed)
    ks = jax.random.split(key, 20)

    def nrm(k, shape, fan_in):
        return jax.random.normal(k, shape, jnp.float32) * (fan_in ** -0.5)

    def gain(k, shape):
        return 1.0 + 0.1 * jax.random.normal(k, shape, jnp.float32)

    L = DEPTH
    return {
        "x": jax.random.normal(ks[0], (BATCH, SEQ, D_MODEL), jnp.float32),
        "p": jax.random.normal(ks[1], (DEPTH, BATCH, SEQ, PLE_DIM), jnp.float32),
        "g_mix": gain(ks[2], (L, D_MODEL)),
        "w_in": nrm(ks[3], (L, D_MODEL, D_IN), D_MODEL),
        "sb_q_gain": gain(ks[4], (L, SB_HEADS, SB_HEAD_DIM)),
        "sb_k_gain": gain(ks[5], (L, SB_HEADS, SB_HEAD_DIM)),
        "ret_norm_gain": gain(ks[6], (L, RET_HEADS, RET_V_DIM)),
        "w_branch_sb": nrm(ks[7], (L, SB_W, D_MODEL), SB_W),
        "w_branch_ret": nrm(ks[8], (L, RET_V_W, D_MODEL), RET_V_W),
        "w_out": nrm(ks[9], (L, D_MODEL, D_MODEL), D_MODEL),
        "g_ffn": gain(ks[10], (L, D_MODEL)),
        "w_up": nrm(ks[11], (L, D_MODEL, 2 * D_FF), D_MODEL),
        "conv_w": nrm(ks[12], (L, CONV_WIDTH, D_FF), CONV_WIDTH),
        "conv_b": 0.02 * jax.random.normal(ks[13], (L, D_FF), jnp.float32),
        "w_down": nrm(ks[14], (L, D_FF, D_MODEL), D_FF),
        "g_ple": gain(ks[15], (L, D_MODEL)),
        "w_ple_gate": nrm(ks[16], (L, D_MODEL, D_MODEL), D_MODEL),
        "w_ple_proj": nrm(ks[17], (L, PLE_DIM, D_MODEL), PLE_DIM),
    }


def reference(x, p, g_mix, w_in, sb_q_gain, sb_k_gain, ret_norm_gain, w_branch_sb,
              w_branch_ret, w_out, g_ffn, w_up, conv_w, conv_b, w_down, g_ple,
              w_ple_gate, w_ple_proj):
    for i in range(DEPTH):
        x = hybrid_layer(x, p[i], g_mix[i], w_in[i], sb_q_gain[i], sb_k_gain[i],
                         ret_norm_gain[i], w_branch_sb[i], w_branch_ret[i], w_out[i],
                         g_ffn[i], w_up[i], conv_w[i], conv_b[i], w_down[i], g_ple[i],
                         w_ple_gate[i], w_ple_proj[i])
    return x
```

```cpp
#include <hip/hip_runtime.h>
#include <stdint.h>
#include <stdio.h>

typedef unsigned short bf16_t;
typedef short bf16x8 __attribute__((ext_vector_type(8)));
typedef float f32x4 __attribute__((ext_vector_type(4)));
typedef float f32x2 __attribute__((ext_vector_type(2)));
typedef unsigned u32x4 __attribute__((ext_vector_type(4)));
typedef unsigned u32x2 __attribute__((ext_vector_type(2)));

constexpr int NB = 16, SEQ = 2048, DM = 1024, M = NB * SEQ;
constexpr int PLE = 256, DIN = 6656, DFF = 2816;
constexpr float EPS = 1e-6f;
constexpr float LOG2E = 1.4426950408889634f;
constexpr size_t MiB = 1u << 20;
constexpr size_t WS_CTL = 0, CTL_ZERO_BYTES = 256 * 1024;
constexpr size_t WS_RSTD0 = 1 * MiB, WS_RSTD1 = WS_RSTD0 + 128 * 1024, WS_RSTD2 = WS_RSTD1 + 128 * 1024;
constexpr size_t WS_ROPE = 2 * MiB;
constexpr size_t WS_W1 = 4 * MiB;
constexpr size_t WS_WAB = WS_W1 + (size_t)DIN * DM * 2;
constexpr size_t WS_WO = WS_WAB + (size_t)DM * 1536 * 2;
constexpr size_t WS_W2 = WS_WO + (size_t)DM * DM * 2;
constexpr size_t WS_W3 = WS_W2 + (size_t)2 * DFF * DM * 2;
constexpr size_t WS_WPG = WS_W3 + (size_t)DM * DFF * 2;
constexpr size_t WS_WPP = WS_WPG + (size_t)DM * DM * 2;
constexpr size_t WS_WEND = WS_WPP + (size_t)DM * PLE * 2;
static_assert(WS_WEND <= 44 * MiB, "weights");
constexpr size_t WS_PART1 = 44 * MiB, WS_PART2 = 46 * MiB;
constexpr size_t WS_QSB = 48 * MiB, WS_KSB = 80 * MiB, WS_VSB = 112 * MiB, WS_QR = 144 * MiB, WS_KR = 176 * MiB, WS_VR = 208 * MiB,
                 WS_SGR = 272 * MiB, WS_SA = 336 * MiB, WS_SB = 400 * MiB, WS_PB = 464 * MiB, WS_MISC = 480 * MiB, WS_END = 512 * MiB;
constexpr size_t WS_T1 = 48 * MiB;
constexpr size_t WS_MERGED = WS_SB;
constexpr size_t WS_X1B = 48 * MiB;
constexpr size_t WS_ARAW = 112 * MiB;
constexpr size_t WS_ACT = 288 * MiB;
constexpr size_t WS_PP2 = 112 * MiB;
constexpr size_t WS_X2B = 176 * MiB;
constexpr size_t WS_HALO = WS_MISC;
constexpr size_t HALO_ELEMS = (size_t)128 * 2 * DFF;
constexpr size_t WS_W2NAT = 492 * MiB;

__device__ __forceinline__ bf16_t f2bf(float f) { unsigned u = __builtin_bit_cast(unsigned, f); return (bf16_t)((u + 0x7fffu + ((u >> 16) & 1u)) >> 16); }
__device__ __forceinline__ float bf2f(bf16_t b) { return __builtin_bit_cast(float, (unsigned)b << 16); }
__device__ __forceinline__ float sigmoidf_(float x) { return 1.f / (1.f + __expf(-x)); }
__device__ __forceinline__ float gelu_tanh(float x) { const float u = 0.7978845608028654f * (x + 0.044715f * x * x * x); return x * sigmoidf_(2.f * u); }
__device__ __forceinline__ float fast_sigmoid(float x) { return __builtin_amdgcn_rcpf(1.f + __builtin_amdgcn_exp2f(-LOG2E * x)); }
__device__ __forceinline__ float sigmoid_z(float z) { return __builtin_amdgcn_rcpf(1.f + __builtin_amdgcn_exp2f(z)); }
__device__ __forceinline__ float fast_gelu(float x) { const float u = x * (-1.5957691216057308f * LOG2E - 0.0713548162726f * LOG2E * x * x); return x * __builtin_amdgcn_rcpf(1.f + __builtin_amdgcn_exp2f(u)); }
__device__ __forceinline__ unsigned cvt_pk_bf16(float lo, float hi) { unsigned r; asm volatile("v_cvt_pk_bf16_f32 %0, %1, %2" : "=v"(r) : "v"(lo), "v"(hi)); return r; }
__device__ __forceinline__ float rstd_part(const float* part, int row) {
    const f32x4* p = (const f32x4*)(part + (size_t)row * 16); const f32x4 a = p[0], b = p[1], c = p[2], d = p[3];
    const float s = ((a[0] + a[1]) + (a[2] + a[3])) + ((b[0] + b[1]) + (b[2] + b[3])) + ((c[0] + c[1]) + (c[2] + c[3])) + ((d[0] + d[1]) + (d[2] + d[3]));
    return 1.0f / sqrtf(s * (1.f / DM) + EPS);
}

namespace pg8 {
#define PG8_LAS __attribute__((address_space(3)))
typedef unsigned short bf16_t;
typedef short bf16x8 __attribute__((ext_vector_type(8)));
typedef float f32x4 __attribute__((ext_vector_type(4)));
typedef unsigned u32x4 __attribute__((ext_vector_type(4)));
constexpr int BM = 256, BK = 64, HALF = 128, HTB = HALF * BK * 2  , STAGE_BYTES = 8 * HTB, NXCD = 8, WGM = 4;

__host__ __device__ __forceinline__ int lds_byte(int r, int c) { const int st = (r >> 4) * 2 + (c >> 5), rr = r & 15, cc = c & 31, ob = rr * 64 + cc * 2; return st * 1024 + (ob ^ (((ob >> 9) & 1) << 5)); }
__host__ __device__ __forceinline__ void stage_rc(int b, int& R, int& C) { const int st = b / 1024, sb = b % 1024, swz = sb ^ (((sb >> 9) & 1) << 5); R = (st >> 1) * 16 + swz / 64; C = (st & 1) * 32 + (swz % 64) / 2; }
__host__ __device__ __forceinline__ int perm32(int rho) { const int n = rho >> 4, i = rho & 15; return 8 * (i >> 2) + 4 * n + (i & 3); }

struct Unit { int pm, pn, part; };
struct Gemm { const bf16_t* A; const bf16_t* Bt; int M, N, K; int lda; const bf16_t* A2; int lda2, pad2; };

struct StaticOrder {
    int nM, nN, nwg, G, c;
    __host__ __device__ void init(int M, int N, int G_, int c_) { nM = M / BM; nN = N / BM; nwg = nM * nN; G = G_; c = c_; }
    __host__ __device__ bool next(int i, Unit& u) const {
        const long L = (long)i * G + c; if (L >= nwg) return false;
        int wgid = (int)L; { const int q = nwg / NXCD, r = nwg % NXCD, xcd = wgid % NXCD, off = wgid / NXCD; wgid = (xcd < r ? xcd * (q + 1) : r * (q + 1) + (xcd - r) * q) + off; }
        const int nig = WGM * nN, gid = wgid / nig, fm = gid * WGM, gsz = (nM - fm) < WGM ? (nM - fm) : WGM;
        u.pm = fm + ((wgid % nig) % gsz); u.pn = (wgid % nig) / gsz; u.part = 0; return true;
    }
    int ntk;
    __device__ __forceinline__ int nt(const Unit&) const { return ntk; }
    __device__ __forceinline__ size_t koff(const Unit&) const { return 0; }
    __device__ __forceinline__ bool a_alt(const Unit&) const { return false; }
    __device__ __forceinline__ void a_ready(const Unit&) const {}
    __device__ __forceinline__ void done(const Unit&) const {}
};


struct PairOrder { StaticOrder base;
    __device__ __forceinline__ bool next(int i, Unit& u) const { if (!base.next(i >> 1, u)) return false; u.part = i & 1; return true; }
    __device__ __forceinline__ int nt(const Unit& u) const { return u.part ? 16 : 8; }
    __device__ __forceinline__ size_t koff(const Unit& u) const { return u.part ? 1024 : 0; }
    __device__ __forceinline__ bool a_alt(const Unit& u) const { return u.part == 0; }
    __device__ __forceinline__ void a_ready(const Unit&) const {}
    __device__ __forceinline__ void done(const Unit&) const {}
};
#define EPI_ARGS f32x4 (&acc)[2][2][4][2], const Unit& u, int wr, int wc, int fr, int fq, PG8_LAS unsigned char* lds, int wid, int lane
struct EpStore { int unused0; int ld; bf16_t* O;
    __device__ __forceinline__ bool keep(const Unit&) const { return false; }
    __device__ __forceinline__ void operator()(EPI_ARGS) const {
        { int l_; asm volatile("v_mbcnt_lo_u32_b32 %0, -1, 0\n\tv_mbcnt_hi_u32_b32 %0, -1, %0" : "=v"(l_)); fr = l_ & 15; fq = l_ >> 4; }
#pragma unroll
        for (int ai = 0; ai < 2; ++ai)
#pragma unroll
            for (int m = 0; m < 4; ++m) { const int row = u.pm * BM + ai * HALF + wr * 64 + m * 16 + fr;
#pragma unroll
                for (int bj = 0; bj < 2; ++bj) { const int col = u.pn * BM + bj * HALF + wc * 32 + 8 * fq; const f32x4 v0 = acc[ai][bj][m][0], v1 = acc[ai][bj][m][1];
                    u32x4 w; w.x = cvt_pk_bf16(v0[0], v0[1]); w.y = cvt_pk_bf16(v0[2], v0[3]); w.z = cvt_pk_bf16(v1[0], v1[1]); w.w = cvt_pk_bf16(v1[2], v1[3]);
                    *(u32x4*)(O + (size_t)row * ld + col) = w; } }
    }
};
template <bool BASE_BF16> struct EpResid { int unused0; int pad; const void* basev; bf16_t* ob; float* part;
    __device__ __forceinline__ bool keep(const Unit&) const { return false; }
    __device__ __forceinline__ void operator()(EPI_ARGS) const {
        { int l_; asm volatile("v_mbcnt_lo_u32_b32 %0, -1, 0\n\tv_mbcnt_hi_u32_b32 %0, -1, %0" : "=v"(l_)); fr = l_ & 15; fq = l_ >> 4; }
#pragma unroll
        for (int ai = 0; ai < 2; ++ai) {
            f32x4 pf32[BASE_BF16 ? 1 : 4][2][2]; u32x4 pb16[BASE_BF16 ? 4 : 1][2];
#pragma unroll
            for (int m = 0; m < 4; ++m)
#pragma unroll
                for (int bj = 0; bj < 2; ++bj) { const size_t o = (size_t)(u.pm * BM + ai * HALF + wr * 64 + m * 16 + fr) * DM + u.pn * BM + bj * HALF + wc * 32 + 8 * fq;
                    if constexpr (BASE_BF16) pb16[m][bj] = *(const u32x4*)((const bf16_t*)basev + o);
                    else { pf32[m][bj][0] = *(const f32x4*)((const float*)basev + o); pf32[m][bj][1] = *(const f32x4*)((const float*)basev + o + 4); } }
#pragma unroll
            for (int m = 0; m < 4; ++m) { const int row = u.pm * BM + ai * HALF + wr * 64 + m * 16 + fr; float ss = 0.f;
#pragma unroll
                for (int bj = 0; bj < 2; ++bj) { const size_t o = (size_t)row * DM + u.pn * BM + bj * HALF + wc * 32 + 8 * fq;
                    f32x4 r0, r1;
                    if constexpr (BASE_BF16) { const u32x4 bw = pb16[m][bj];
                        r0 = (f32x4){__builtin_bit_cast(float, bw.x << 16), __builtin_bit_cast(float, bw.x & 0xffff0000u), __builtin_bit_cast(float, bw.y << 16), __builtin_bit_cast(float, bw.y & 0xffff0000u)};
                        r1 = (f32x4){__builtin_bit_cast(float, bw.z << 16), __builtin_bit_cast(float, bw.z & 0xffff0000u), __builtin_bit_cast(float, bw.w << 16), __builtin_bit_cast(float, bw.w & 0xffff0000u)}; }
                    else { r0 = pf32[m][bj][0]; r1 = pf32[m][bj][1]; }
                    r0 = r0 + acc[ai][bj][m][0]; r1 = r1 + acc[ai][bj][m][1];
                    ss += (r0[0] * r0[0] + r0[1] * r0[1]) + (r0[2] * r0[2] + r0[3] * r0[3]) + (r1[0] * r1[0] + r1[1] * r1[1]) + (r1[2] * r1[2] + r1[3] * r1[3]);
                    u32x4 w; w.x = cvt_pk_bf16(r0[0], r0[1]); w.y = cvt_pk_bf16(r0[2], r0[3]); w.z = cvt_pk_bf16(r1[0], r1[1]); w.w = cvt_pk_bf16(r1[2], r1[3]);
                    *(u32x4*)(ob + o) = w; }
                ss += __shfl_xor(ss, 16); ss += __shfl_xor(ss, 32);
                if (fq == 0) part[(size_t)row * 16 + u.pn * 4 + wc] = ss; }
            asm volatile("" ::: "memory"); }
    }
};
struct EpFinalP { int pm0; int wgm; const float* part; const bf16_t* pp; const bf16_t* x2b; float* out;
    __device__ __forceinline__ bool keep(const Unit&) const { return false; }
    __device__ __forceinline__ void operator()(EPI_ARGS) const {
        { int l_; asm volatile("v_mbcnt_lo_u32_b32 %0, -1, 0\n\tv_mbcnt_hi_u32_b32 %0, -1, %0" : "=v"(l_)); fr = l_ & 15; fq = l_ >> 4; }
#pragma unroll
        for (int ai = 0; ai < 2; ++ai) {
            u32x4 pwv[4][2], xwv[4][2];
#pragma unroll
            for (int m = 0; m < 4; ++m)
#pragma unroll
                for (int bj = 0; bj < 2; ++bj) { const size_t o = (size_t)(u.pm * BM + ai * HALF + wr * 64 + m * 16 + fr) * DM + u.pn * BM + bj * HALF + wc * 32 + 8 * fq; pwv[m][bj] = *(const u32x4*)(pp + o); xwv[m][bj] = *(const u32x4*)(x2b + o); }
#pragma unroll
            for (int m = 0; m < 4; ++m) { const int row = u.pm * BM + ai * HALF + wr * 64 + m * 16 + fr;
                const float rs = ((const PG8_LAS float*)(lds + 131072 + 1024 + 4096))[((u.pm - pm0) / wgm) * 256 + ai * HALF + wr * 64 + m * 16 + fr];
#pragma unroll
                for (int bj = 0; bj < 2; ++bj) { const size_t o = (size_t)row * DM + u.pn * BM + bj * HALF + wc * 32 + 8 * fq;
                    const u32x4 pw = pwv[m][bj], xw = xwv[m][bj];
                    const float rsl = -LOG2E * rs; const f32x4 a0 = acc[ai][bj][m][0] * rsl, a1 = acc[ai][bj][m][1] * rsl; f32x4 r0, r1;
#define LO_(w) __builtin_bit_cast(float, (w) << 16)
#define HI_(w) __builtin_bit_cast(float, (w) & 0xffff0000u)
                    r0[0] = LO_(xw.x) + sigmoid_z(a0[0]) * LO_(pw.x); r0[1] = HI_(xw.x) + sigmoid_z(a0[1]) * HI_(pw.x); r0[2] = LO_(xw.y) + sigmoid_z(a0[2]) * LO_(pw.y); r0[3] = HI_(xw.y) + sigmoid_z(a0[3]) * HI_(pw.y);
                    r1[0] = LO_(xw.z) + sigmoid_z(a1[0]) * LO_(pw.z); r1[1] = HI_(xw.z) + sigmoid_z(a1[1]) * HI_(pw.z); r1[2] = LO_(xw.w) + sigmoid_z(a1[2]) * LO_(pw.w); r1[3] = HI_(xw.w) + sigmoid_z(a1[3]) * HI_(pw.w);
#undef LO_
#undef HI_
                    *(f32x4*)(out + o) = r0; *(f32x4*)(out + o + 4) = r1; } }
            asm volatile("" ::: "memory"); }
    }
};
struct EpMerged { int unused0; int pad; const bf16_t* sA; bf16_t* sB;
    __device__ __forceinline__ bool keep(const Unit& u) const { return u.part == 0; }
    __device__ __forceinline__ void ratio(f32x4 (&acc)[2][2][4][2], const Unit& u, int wr, int wc, int fr, int fq) const {
#pragma unroll
        for (int ai = 0; ai < 2; ++ai) {
            u32x4 rv[4][2];
#pragma unroll
            for (int m = 0; m < 4; ++m)
#pragma unroll
                for (int bj = 0; bj < 2; ++bj) rv[m][bj] = *(const u32x4*)(sA + (size_t)(u.pm * BM + ai * HALF + wr * 64 + m * 16 + fr) * DM + u.pn * BM + bj * HALF + wc * 32 + 8 * fq);
#pragma unroll
            for (int m = 0; m < 4; ++m)
#pragma unroll
                for (int bj = 0; bj < 2; ++bj) { const u32x4 a = rv[m][bj];
                    acc[ai][bj][m][0][0] *= __builtin_bit_cast(float, a.x << 16); acc[ai][bj][m][0][1] *= __builtin_bit_cast(float, a.x & 0xffff0000u); acc[ai][bj][m][0][2] *= __builtin_bit_cast(float, a.y << 16); acc[ai][bj][m][0][3] *= __builtin_bit_cast(float, a.y & 0xffff0000u);
                    acc[ai][bj][m][1][0] *= __builtin_bit_cast(float, a.z << 16); acc[ai][bj][m][1][1] *= __builtin_bit_cast(float, a.z & 0xffff0000u); acc[ai][bj][m][1][2] *= __builtin_bit_cast(float, a.w << 16); acc[ai][bj][m][1][3] *= __builtin_bit_cast(float, a.w & 0xffff0000u); }
            asm volatile("" ::: "memory"); }
    }
    __device__ __forceinline__ void operator()(EPI_ARGS) const {
        { int l_; asm volatile("v_mbcnt_lo_u32_b32 %0, -1, 0\n\tv_mbcnt_hi_u32_b32 %0, -1, %0" : "=v"(l_)); fr = l_ & 15; fq = l_ >> 4; }
        if (u.part == 0) { ratio(acc, u, wr, wc, fr, fq); return; }
#pragma unroll
        for (int ai = 0; ai < 2; ++ai) {
            u32x4 bv[4][2];
#pragma unroll
            for (int m = 0; m < 4; ++m)
#pragma unroll
                for (int bj = 0; bj < 2; ++bj) bv[m][bj] = *(const u32x4*)(sB + (size_t)(u.pm * BM + ai * HALF + wr * 64 + m * 16 + fr) * DM + u.pn * BM + bj * HALF + wc * 32 + 8 * fq);
#pragma unroll
            for (int m = 0; m < 4; ++m) { const int row = u.pm * BM + ai * HALF + wr * 64 + m * 16 + fr;
#pragma unroll
                for (int bj = 0; bj < 2; ++bj) { const size_t o = (size_t)row * DM + u.pn * BM + bj * HALF + wc * 32 + 8 * fq;
                    const u32x4 b = bv[m][bj]; const f32x4 v0 = acc[ai][bj][m][0], v1 = acc[ai][bj][m][1];
#define LO(w) fmaxf(__builtin_bit_cast(float, (w) << 16), 1e-30f)
#define HI(w) fmaxf(__builtin_bit_cast(float, (w) & 0xffff0000u), 1e-30f)
                    u32x4 w; w.x = cvt_pk_bf16(v0[0] * LO(b.x), v0[1] * HI(b.x)); w.y = cvt_pk_bf16(v0[2] * LO(b.y), v0[3] * HI(b.y));
                    w.z = cvt_pk_bf16(v1[0] * LO(b.z), v1[1] * HI(b.z)); w.w = cvt_pk_bf16(v1[2] * LO(b.w), v1[3] * HI(b.w));
#undef LO
#undef HI
                    *(u32x4*)(sB + o) = w; } }
            asm volatile("" ::: "memory"); }
    }
};
struct EpProj { int pn_base; int pad; const float* rstd0; unsigned char* ws; const float* gq; const float* gk; const float* rope;
    __device__ __forceinline__ bool keep(const Unit&) const { return false; }
    __device__ __forceinline__ void operator()(EPI_ARGS) const {
        { int l_; asm volatile("v_mbcnt_lo_u32_b32 %0, -1, 0\n\tv_mbcnt_hi_u32_b32 %0, -1, %0" : "=v"(l_)); fr = l_ & 15; fq = l_ >> 4; }
        const int pn = u.pn + pn_base;
        if (pn < 4) {
            const bool isq = pn < 2; bf16_t* dst = (bf16_t*)(ws + (isq ? WS_QSB : WS_KSB)); const float* gain = isq ? gq : gk; const float scale = isq ? 0.125f * LOG2E : 1.f;
            const int h = 4 * (pn & 1) + wc;
            f32x4 gv[2][2];
#pragma unroll
            for (int bj = 0; bj < 2; ++bj)
#pragma unroll
                for (int n = 0; n < 2; ++n) gv[bj][n] = *(const f32x4*)(gain + h * 64 + 32 * bj + 8 * fq + 4 * n);
#pragma unroll
            for (int ai = 0; ai < 2; ++ai)
#pragma unroll
                for (int m = 0; m < 4; ++m) { const int row = u.pm * BM + ai * HALF + wr * 64 + m * 16 + fr; const float rs = rstd0[row];
                    f32x4 v[2][2]; float ss = 0.f;
#pragma unroll
                    for (int bj = 0; bj < 2; ++bj)
#pragma unroll
                        for (int n = 0; n < 2; ++n) { v[bj][n] = acc[ai][bj][m][n] * rs; ss += (v[bj][n][0] * v[bj][n][0] + v[bj][n][1] * v[bj][n][1]) + (v[bj][n][2] * v[bj][n][2] + v[bj][n][3] * v[bj][n][3]); }
                    ss += __shfl_xor(ss, 16); ss += __shfl_xor(ss, 32);
                    const float r = scale / sqrtf(ss * (1.f / 64.f) + EPS);
#pragma unroll
                    for (int bj = 0; bj < 2; ++bj) { const f32x4 o0 = v[bj][0] * gv[bj][0] * r, o1 = v[bj][1] * gv[bj][1] * r;
                        u32x4 w; w.x = cvt_pk_bf16(o0[0], o0[1]); w.y = cvt_pk_bf16(o0[2], o0[3]); w.z = cvt_pk_bf16(o1[0], o1[1]); w.w = cvt_pk_bf16(o1[2], o1[3]);
                        *(u32x4*)(dst + (size_t)row * 512 + h * 64 + 32 * bj + 8 * fq) = w; } }
        } else if (pn >= 6 && pn < 10) {
            const bool isq = pn < 8; bf16_t* dst = (bf16_t*)(ws + (isq ? WS_QR : WS_KR)); const int h = 4 * (pn & 1) + wc;
            const float lg = log2f(1.f - exp2f(-5.f - (float)h));
#pragma unroll
            for (int ai = 0; ai < 2; ++ai)
#pragma unroll
                for (int m = 0; m < 4; ++m) { const int row = u.pm * BM + ai * HALF + wr * 64 + m * 16 + fr; const int t = row & (SEQ - 1); const float ic = (float)(t & 127);
                    const float sc = rstd0[row] * (isq ? exp2f(lg * ic) : 0.125f * exp2f(-lg * ic));
                    u32x4 w1, w2;
#pragma unroll
                    for (int n = 0; n < 2; ++n) { const f32x4 c = *(const f32x4*)(rope + (size_t)t * 32 + 8 * fq + 4 * n), s = *(const f32x4*)(rope + (size_t)SEQ * 32 + (size_t)t * 32 + 8 * fq + 4 * n);
                        const f32x4 x1 = acc[ai][0][m][n], x2 = acc[ai][1][m][n]; const f32x4 o1 = (x1 * c - x2 * s) * sc, o2 = (x1 * s + x2 * c) * sc;
                        if (n == 0) { w1.x = cvt_pk_bf16(o1[0], o1[1]); w1.y = cvt_pk_bf16(o1[2], o1[3]); w2.x = cvt_pk_bf16(o2[0], o2[1]); w2.y = cvt_pk_bf16(o2[2], o2[3]); }
                        else { w1.z = cvt_pk_bf16(o1[0], o1[1]); w1.w = cvt_pk_bf16(o1[2], o1[3]); w2.z = cvt_pk_bf16(o2[0], o2[1]); w2.w = cvt_pk_bf16(o2[2], o2[3]); } }
                    bf16_t* dp = dst + ((size_t)((row >> 11) * 8 + h) * SEQ + t) * 64 + 8 * fq;
                    *(u32x4*)dp = w1; *(u32x4*)(dp + 32) = w2; }
        } else if (pn >= 18) {
            bf16_t* dR = (bf16_t*)(ws + WS_SA); bf16_t* dB = (bf16_t*)(ws + WS_SB); const int c0 = (pn - 18) * 128 + wc * 32 + 8 * fq;
#pragma unroll
            for (int ai = 0; ai < 2; ++ai)
#pragma unroll
                for (int m = 0; m < 4; ++m) { const int row = u.pm * BM + ai * HALF + wr * 64 + m * 16 + fr; const float rsl = -LOG2E * rstd0[row];
                    f32x4 rr[2], sb[2];
#pragma unroll
                    for (int n = 0; n < 2; ++n)
#pragma unroll
                        for (int i = 0; i < 4; ++i) {
                            const float da = 1.f + __builtin_amdgcn_exp2f(acc[ai][0][m][n][i] * rsl), db = 1.f + __builtin_amdgcn_exp2f(fminf(acc[ai][1][m][n][i] * rsl, 100.f));
                            sb[n][i] = __builtin_amdgcn_rcpf(db); rr[n][i] = db * __builtin_amdgcn_rcpf(da); }
                    u32x4 w; w.x = cvt_pk_bf16(rr[0][0], rr[0][1]); w.y = cvt_pk_bf16(rr[0][2], rr[0][3]); w.z = cvt_pk_bf16(rr[1][0], rr[1][1]); w.w = cvt_pk_bf16(rr[1][2], rr[1][3]);
                    *(u32x4*)(dR + (size_t)row * DM + c0) = w;
                    u32x4 x; x.x = cvt_pk_bf16(sb[0][0], sb[0][1]); x.y = cvt_pk_bf16(sb[0][2], sb[0][3]); x.z = cvt_pk_bf16(sb[1][0], sb[1][1]); x.w = cvt_pk_bf16(sb[1][2], sb[1][3]);
                    *(u32x4*)(dB + (size_t)row * DM + c0) = x; }
        } else {
            bf16_t* dst; int ld, cbase, actk;
            if (pn < 6) { dst = (bf16_t*)(ws + WS_VSB); ld = 512; cbase = (pn - 4) * 256; actk = 0; }
            else if (pn < 14) { dst = (bf16_t*)(ws + WS_VR); ld = 1024; cbase = (pn - 10) * 256; actk = 0; }
            else if (pn < 18) { dst = (bf16_t*)(ws + WS_SGR); ld = 1024; cbase = (pn - 14) * 256; actk = 1; }
            else if (pn < 22) { dst = (bf16_t*)(ws + WS_SA); ld = 1024; cbase = (pn - 18) * 256; actk = 2; }
            else { dst = (bf16_t*)(ws + WS_SB); ld = 1024; cbase = (pn - 22) * 256; actk = 2; }
#pragma unroll
            for (int ai = 0; ai < 2; ++ai)
#pragma unroll
                for (int m = 0; m < 4; ++m) { const int row = u.pm * BM + ai * HALF + wr * 64 + m * 16 + fr; const float rs = rstd0[row];
#pragma unroll
                    for (int bj = 0; bj < 2; ++bj) { f32x4 v0 = acc[ai][bj][m][0] * rs, v1 = acc[ai][bj][m][1] * rs;
                        if (actk) { const float rsl = -LOG2E * rs; const f32x4 z0 = acc[ai][bj][m][0] * rsl, z1 = acc[ai][bj][m][1] * rsl;
#pragma unroll
                            for (int i = 0; i < 4; ++i) { const float s0 = sigmoid_z(z0[i]), s1 = sigmoid_z(z1[i]); v0[i] = actk == 1 ? v0[i] * s0 : s0; v1[i] = actk == 1 ? v1[i] * s1 : s1; } }
                        u32x4 w; w.x = cvt_pk_bf16(v0[0], v0[1]); w.y = cvt_pk_bf16(v0[2], v0[3]); w.z = cvt_pk_bf16(v1[0], v1[1]); w.w = cvt_pk_bf16(v1[2], v1[3]);
                        if (pn >= 10 && pn < 18) *(u32x4*)(dst + ((size_t)((row >> 11) * 8 + (cbase >> 7) + bj) * SEQ + (row & (SEQ - 1))) * 128 + wc * 32 + 8 * fq) = w;
                        else *(u32x4*)(dst + (size_t)row * ld + cbase + bj * HALF + wc * 32 + 8 * fq) = w; } }
        }
    }
};
__device__ __forceinline__ float dpp_ror1(float v) { return __builtin_bit_cast(float, __builtin_amdgcn_update_dpp(0, __builtin_bit_cast(int, v), 0x121, 0xF, 0xF, false)); }
__device__ __forceinline__ float dpp_ror2(float v) { return __builtin_bit_cast(float, __builtin_amdgcn_update_dpp(0, __builtin_bit_cast(int, v), 0x122, 0xF, 0xF, false)); }
struct EpUp { int pm0; int wgm; const float* part1; const float* cw; const float* cb; bf16_t* act; float* halo;
    __device__ __forceinline__ bool keep(const Unit&) const { return false; }
    __device__ __forceinline__ void operator()(EPI_ARGS) const {
        { int l_; asm volatile("v_mbcnt_lo_u32_b32 %0, -1, 0\n\tv_mbcnt_hi_u32_b32 %0, -1, %0" : "=v"(l_)); fr = l_ & 15; fq = l_ >> 4; }
        const int ch0 = u.pn * 128 + wc * 32 + 8 * fq;
        PG8_LAS float* X = (PG8_LAS float*)(lds + 131072 + 1024);
        f32x4 cw0[2], cw1[2], cw2[2], cbb[2];
#pragma unroll
        for (int n = 0; n < 2; ++n) { cw0[n] = *(const f32x4*)(cw + ch0 + 4 * n); cw1[n] = *(const f32x4*)(cw + DFF + ch0 + 4 * n); cw2[n] = *(const f32x4*)(cw + 2 * DFF + ch0 + 4 * n); cbb[n] = *(const f32x4*)(cb + ch0 + 4 * n); }
        float rsv[2][4];
#pragma unroll
        for (int ai = 0; ai < 2; ++ai)
#pragma unroll
            for (int m = 0; m < 4; ++m) rsv[ai][m] = ((const PG8_LAS float*)(lds + 131072 + 1024 + 4096))[((u.pm - pm0) / wgm) * 256 + ai * HALF + wr * 64 + m * 16 + fr];
        if (fr >= 14) {
#pragma unroll
            for (int ai = 0; ai < 2; ++ai)
#pragma unroll
                for (int n = 0; n < 2; ++n) *(PG8_LAS f32x4*)(X + (((ai * 2 + wr) * 4 + wc) * 2 + (fr - 14)) * 32 + 8 * fq + 4 * n) = acc[ai][0][3][n] * rsv[ai][3];
            if (wr == 1) {
#pragma unroll
                for (int n = 0; n < 2; ++n) *(f32x4*)(halo + ((size_t)u.pm * 2 + (fr - 14)) * DFF + ch0 + 4 * n) = acc[1][0][3][n] * rsv[1][3]; }
        }
        if (fr < 2 && wr == 0) {
#pragma unroll
            for (int n = 0; n < 2; ++n) { *(f32x4*)(halo + HALO_ELEMS + ((size_t)u.pm * 2 + fr) * DFF + ch0 + 4 * n) = acc[0][0][0][n] * rsv[0][0];
                                          *(f32x4*)(halo + 2 * HALO_ELEMS + ((size_t)u.pm * 2 + fr) * DFF + ch0 + 4 * n) = acc[0][1][0][n] * rsv[0][0]; }
        }
        asm volatile("s_waitcnt lgkmcnt(0)" ::: "memory"); __builtin_amdgcn_s_barrier(); asm volatile("" ::: "memory");
        const bool l15 = fr == 15, l14 = fr >= 14;
#pragma unroll
        for (int n = 0; n < 2; ++n) {
            const f32x4 w0 = cw0[n], w1 = cw1[n], w2 = cw2[n], bb = cbb[n];
#pragma unroll
            for (int ai = 0; ai < 2; ++ai) {
                f32x4 pv;
#pragma unroll
                for (int m = 0; m < 4; ++m) { const int row = u.pm * BM + ai * HALF + wr * 64 + m * 16 + fr;
                    const f32x4 cur = acc[ai][0][m][n] * rsv[ai][m];
                    f32x4 e1, e2;
                    if (m == 0) {
                        const int sai = wr == 1 ? ai : ai - 1, swr = wr == 1 ? 0 : 1;
                        if (sai >= 0) { const f32x4 q14 = *(const PG8_LAS f32x4*)(X + (((sai * 2 + swr) * 4 + wc) * 2 + 0) * 32 + 8 * fq + 4 * n); e1 = *(const PG8_LAS f32x4*)(X + (((sai * 2 + swr) * 4 + wc) * 2 + 1) * 32 + 8 * fq + 4 * n);
#pragma unroll
                            for (int i = 0; i < 4; ++i) e2[i] = l15 ? e1[i] : q14[i]; }
                        else { e1 = e2 = (f32x4){0.f, 0.f, 0.f, 0.f}; }
                    } else { e1 = pv; e2 = pv; }
                    f32x4 t1, t2; f32x4 c = bb + w2 * cur;
#pragma unroll
                    for (int i = 0; i < 4; ++i) { t1[i] = l15 ? e1[i] : cur[i]; t2[i] = l14 ? e2[i] : cur[i]; }
                    asm("s_nop 1\n\t"
                        "v_fmac_f32_dpp %0, %4, %12 row_ror:1 row_mask:0xf bank_mask:0xf\n\tv_fmac_f32_dpp %1, %5, %13 row_ror:1 row_mask:0xf bank_mask:0xf\n\t"
                        "v_fmac_f32_dpp %2, %6, %14 row_ror:1 row_mask:0xf bank_mask:0xf\n\tv_fmac_f32_dpp %3, %7, %15 row_ror:1 row_mask:0xf bank_mask:0xf\n\t"
                        "v_fmac_f32_dpp %0, %8, %16 row_ror:2 row_mask:0xf bank_mask:0xf\n\tv_fmac_f32_dpp %1, %9, %17 row_ror:2 row_mask:0xf bank_mask:0xf\n\t"
                        "v_fmac_f32_dpp %2, %10, %18 row_ror:2 row_mask:0xf bank_mask:0xf\n\tv_fmac_f32_dpp %3, %11, %19 row_ror:2 row_mask:0xf bank_mask:0xf"
                        : "+v"(c[0]), "+v"(c[1]), "+v"(c[2]), "+v"(c[3])
                        : "v"(t1[0]), "v"(t1[1]), "v"(t1[2]), "v"(t1[3]), "v"(t2[0]), "v"(t2[1]), "v"(t2[2]), "v"(t2[3]),
                          "v"(w1[0]), "v"(w1[1]), "v"(w1[2]), "v"(w1[3]), "v"(w0[0]), "v"(w0[1]), "v"(w0[2]), "v"(w0[3]));
                    const f32x4 uu = acc[ai][1][m][n] * rsv[ai][m];
                    u32x2 w; w.x = cvt_pk_bf16(fast_gelu(c[0]) * uu[0], fast_gelu(c[1]) * uu[1]); w.y = cvt_pk_bf16(fast_gelu(c[2]) * uu[2], fast_gelu(c[3]) * uu[3]);
                    if (!(ai == 0 && m == 0 && wr == 0 && fr < 2)) *(u32x2*)(act + (size_t)row * DFF + ch0 + 4 * n) = w;
                    pv = cur;
                    if (m & 1) asm volatile("" ::: "memory"); }
            }
        }
        asm volatile("s_waitcnt lgkmcnt(0)" ::: "memory"); __builtin_amdgcn_s_barrier(); asm volatile("" ::: "memory");
    }
};

template <class Epi, class Sched, bool ALIGN_EPI = false, bool SP2 = false, bool VARA = false>
__device__ __forceinline__ void gemm_phase(PG8_LAS unsigned char* lds, const Gemm g, const Sched& S, const Epi& E, const int wid) {
    int lane; asm volatile("v_mbcnt_lo_u32_b32 %0, -1, 0\n\tv_mbcnt_hi_u32_b32 %0, -1, %0" : "=v"(lane));
    const int tid = wid * 64 + lane, wr = wid >> 2, wc = wid & 3, fr = lane & 15, fq = lane >> 4;
    const int K = g.K;
    const int lda = g.lda ? g.lda : K, lda2 = VARA ? g.lda2 : 0;
    unsigned voffA[2], voffB[2], voffA2[2];
#pragma unroll
    for (int i = 0; i < 2; ++i) { int R, C; stage_rc(tid * 16 + i * 8192, R, C); const int Rb = (R & ~31) + perm32(R & 31);
        voffA[i] = (unsigned)(R * lda + C) * 2u; voffB[i] = (unsigned)(Rb * K + C) * 2u; voffA2[i] = (unsigned)(R * lda2 + C) * 2u; }
    const size_t kstep = (size_t)(BK * 2);
    const size_t hstep = (size_t)HALF * K * 2;
    const size_t tstep = 2 * hstep;
    const size_t hstepA = (size_t)HALF * lda * 2, hstepA2 = (size_t)HALF * lda2 * 2;
#define PG8_ABASE(u_) ((VARA && S.a_alt(u_)) ? (const char*)g.A2 + (size_t)(u_).pm * 2 * hstepA2 : (const char*)g.A + (size_t)(u_).pm * 2 * hstepA + (VARA ? (size_t)0 : S.koff(u_)))
    const unsigned ldsw = (unsigned)wid * 1024u;
    const int aoff = lds_byte(wr * 64 + fr, fq * 8), boff = lds_byte(wc * 32 + fr, fq * 8);
#define PG8_SA(b, h) (((b) * 2 + (h)) * HTB)
#define PG8_SB(b, h) ((4 + (b) * 2 + (h)) * HTB)
#define PG8_STAGE(bufoff, gbase, voff) do { _Pragma("unroll") for (int _i = 0; _i < 2; ++_i) \
        __builtin_amdgcn_global_load_lds((const unsigned*)((const char*)(gbase) + (voff)[_i]), (PG8_LAS unsigned*)(lds + (bufoff) + ldsw + _i * 8192), 16, 0, 0); } while (0)
#define PG8_LDA(dst, b, h) do { _Pragma("unroll") for (int m = 0; m < 4; ++m) _Pragma("unroll") for (int k = 0; k < 2; ++k) dst[m][k] = *(const PG8_LAS bf16x8*)(lds + PG8_SA(b, h) + aoff + m * 2048 + k * 1024); } while (0)
#define PG8_LDB(dst, b, h) do { _Pragma("unroll") for (int n = 0; n < 2; ++n) _Pragma("unroll") for (int k = 0; k < 2; ++k) dst[n][k] = *(const PG8_LAS bf16x8*)(lds + PG8_SB(b, h) + boff + n * 2048 + k * 1024); } while (0)
#define PG8_MMA(ai, bj, At, Bt) do { __builtin_amdgcn_s_setprio(1); _Pragma("unroll") for (int m = 0; m < 4; ++m) _Pragma("unroll") for (int n = 0; n < 2; ++n) _Pragma("unroll") for (int k = 0; k < 2; ++k) \
        acc[ai][bj][m][n] = __builtin_amdgcn_mfma_f32_16x16x32_bf16(Bt[n][k], At[m][k], acc[ai][bj][m][n], 0, 0, 0); __builtin_amdgcn_s_setprio(0); } while (0)
#define PG8_WAIT_V(n) asm volatile("s_waitcnt vmcnt(" #n ")" ::: "memory")
#define PG8_WAIT_L(n) asm volatile("s_waitcnt lgkmcnt(" #n ")" ::: "memory")
#define PG8_BAR __builtin_amdgcn_s_barrier()
#define PG8_SCHED __builtin_amdgcn_sched_barrier(0)
    Unit cur, nxt; int ui = 0;
    if (!S.next(0, cur)) return;
    f32x4 acc[2][2][4][2];
#pragma unroll
    for (int a = 0; a < 2; ++a)
#pragma unroll
        for (int b = 0; b < 2; ++b)
#pragma unroll
            for (int m = 0; m < 4; ++m)
#pragma unroll
                for (int n = 0; n < 2; ++n) acc[a][b][m][n] = (f32x4){0.f, 0.f, 0.f, 0.f};
    bf16x8 At[4][2], B0[2][2], B1[2][2];
    const char* cA = PG8_ABASE(cur); const char* cB = (const char*)g.Bt + (size_t)cur.pn * tstep + S.koff(cur);
    S.a_ready(cur);
    if constexpr (SP2) {
        const bool alt0 = VARA && S.a_alt(cur); const unsigned vA0[2] = {alt0 ? voffA2[0] : voffA[0], alt0 ? voffA2[1] : voffA[1]}; const size_t hA0 = alt0 ? hstepA2 : hstepA;
        PG8_STAGE(PG8_SB(0, 0), cB, voffB); PG8_STAGE(PG8_SB(0, 1), cB + hstep, voffB); PG8_STAGE(PG8_SA(0, 0), cA, vA0); PG8_STAGE(PG8_SA(0, 1), cA + hA0, vA0);
        if (wr == 1) PG8_BAR;
        PG8_WAIT_V(2); PG8_BAR;
        PG8_STAGE(PG8_SB(1, 0), cB + kstep, voffB); PG8_STAGE(PG8_SA(1, 0), cA + kstep, vA0); PG8_STAGE(PG8_SB(1, 1), cB + hstep + kstep, voffB);
        PG8_WAIT_V(6); PG8_BAR;
    } else {
        PG8_STAGE(PG8_SB(0, 0), cB, voffB); PG8_STAGE(PG8_SA(0, 0), cA, voffA); PG8_STAGE(PG8_SB(0, 1), cB + hstep, voffB); PG8_STAGE(PG8_SA(0, 1), cA + hstep, voffA);
        if (wr == 1) PG8_BAR;
        PG8_WAIT_V(4); PG8_BAR;
        PG8_STAGE(PG8_SB(1, 0), cB + kstep, voffB); PG8_STAGE(PG8_SA(1, 0), cA + kstep, voffA); PG8_STAGE(PG8_SB(1, 1), cB + hstep + kstep, voffB);
        PG8_WAIT_V(6); PG8_BAR;
    }
    for (;;) {
        const bool has_next = S.next(ui + 1, nxt);
        const int nt = S.nt(cur);
        const char* nA = has_next ? PG8_ABASE(nxt) : cA; const char* nB = has_next ? (const char*)g.Bt + (size_t)nxt.pn * tstep + S.koff(nxt) : cB;
        for (int t = 0; t < nt; t += 2) {
            const bool last = (t == nt - 2);
            const char* a1 = cA + (size_t)(t + 1) * kstep;
            const char* a2 = last ? nA : cA + (size_t)(t + 2) * kstep; const char* b2 = last ? nB : cB + (size_t)(t + 2) * kstep;
            const char* a3 = a2 + kstep; const char* b3 = b2 + kstep;
            if (last && has_next) S.a_ready(nxt);
            const bool altc = VARA && S.a_alt(cur), alt2 = VARA && ((last && has_next) ? S.a_alt(nxt) : S.a_alt(cur));
            const unsigned vAc[2] = {altc ? voffA2[0] : voffA[0], altc ? voffA2[1] : voffA[1]}, vA2[2] = {alt2 ? voffA2[0] : voffA[0], alt2 ? voffA2[1] : voffA[1]};
            const size_t hAc = altc ? hstepA2 : hstepA, hA2 = alt2 ? hstepA2 : hstepA;
            if constexpr (SP2) {
            PG8_LDB(B0, 0, 0); PG8_LDB(B1, 0, 1); PG8_SCHED; PG8_LDA(At, 0, 0); PG8_STAGE(PG8_SA(1, 1), a1 + hAc, vAc);
            PG8_WAIT_V(8); PG8_WAIT_L(0); PG8_BAR; PG8_MMA(0, 0, At, B0); PG8_MMA(0, 1, At, B1); PG8_BAR; PG8_SCHED;
            PG8_LDA(At, 0, 1); PG8_STAGE(PG8_SB(0, 0), b2, voffB); PG8_STAGE(PG8_SB(0, 1), b2 + hstep, voffB); PG8_STAGE(PG8_SA(0, 0), a2, vA2);
            PG8_WAIT_V(8); PG8_WAIT_L(0); PG8_BAR; PG8_MMA(1, 0, At, B0); PG8_MMA(1, 1, At, B1); PG8_BAR; PG8_SCHED;
            PG8_LDB(B0, 1, 0); PG8_LDB(B1, 1, 1); PG8_SCHED; PG8_LDA(At, 1, 0); PG8_STAGE(PG8_SA(0, 1), a2 + hA2, vA2);
            PG8_WAIT_V(8); PG8_WAIT_L(0); PG8_BAR; PG8_MMA(0, 0, At, B0); PG8_MMA(0, 1, At, B1); PG8_BAR; PG8_SCHED;
            PG8_LDA(At, 1, 1); PG8_STAGE(PG8_SB(1, 0), b3, voffB); PG8_STAGE(PG8_SB(1, 1), b3 + hstep, voffB); PG8_STAGE(PG8_SA(1, 0), a3, vA2);
            PG8_WAIT_V(8); PG8_WAIT_L(0); PG8_BAR; PG8_MMA(1, 0, At, B0); PG8_MMA(1, 1, At, B1); PG8_BAR; PG8_SCHED;
            } else {
            PG8_LDB(B0, 0, 0); PG8_SCHED; PG8_LDA(At, 0, 0); PG8_STAGE(PG8_SA(1, 1), a1 + hstep, voffA);
            PG8_WAIT_L(8); PG8_BAR; PG8_WAIT_L(0); PG8_MMA(0, 0, At, B0); PG8_BAR; PG8_SCHED;
            PG8_LDB(B1, 0, 1); PG8_STAGE(PG8_SB(0, 0), b2, voffB);
            PG8_BAR; PG8_WAIT_L(0); PG8_MMA(0, 1, At, B1); PG8_BAR;
            PG8_LDA(At, 0, 1); PG8_STAGE(PG8_SA(0, 0), a2, voffA);
            PG8_BAR; PG8_WAIT_L(0); PG8_MMA(1, 0, At, B0); PG8_BAR; PG8_SCHED;
            PG8_STAGE(PG8_SB(0, 1), b2 + hstep, voffB);
            PG8_WAIT_V(6); PG8_BAR; PG8_MMA(1, 1, At, B1); PG8_BAR;
            PG8_LDB(B0, 1, 0); PG8_SCHED; PG8_LDA(At, 1, 0); PG8_STAGE(PG8_SA(0, 1), a2 + hstep, voffA);
            PG8_WAIT_L(8); PG8_BAR; PG8_WAIT_L(0); PG8_MMA(0, 0, At, B0); PG8_BAR; PG8_SCHED;
            PG8_LDB(B1, 1, 1); PG8_STAGE(PG8_SB(1, 0), b3, voffB);
            PG8_BAR; PG8_WAIT_L(0); PG8_MMA(0, 1, At, B1); PG8_BAR;
            PG8_LDA(At, 1, 1); PG8_STAGE(PG8_SA(1, 0), a3, voffA);
            PG8_BAR; PG8_WAIT_L(0); PG8_MMA(1, 0, At, B0); PG8_BAR; PG8_SCHED;
            PG8_STAGE(PG8_SB(1, 1), b3 + hstep, voffB);
            PG8_WAIT_V(6); PG8_BAR; PG8_MMA(1, 1, At, B1); PG8_BAR;
            }
        }
        if constexpr (ALIGN_EPI) { if (wr == 0) PG8_BAR; }
        E(acc, cur, wr, wc, fr, fq, lds, wid, lane); S.done(cur);
        if (!has_next) break;
        if (!E.keep(cur))
#pragma unroll
        for (int a = 0; a < 2; ++a)
#pragma unroll
            for (int b = 0; b < 2; ++b)
#pragma unroll
                for (int m = 0; m < 4; ++m)
#pragma unroll
                    for (int n = 0; n < 2; ++n) acc[a][b][m][n] = (f32x4){0.f, 0.f, 0.f, 0.f};
        cur = nxt; cA = nA; cB = nB; ++ui;
        if constexpr (ALIGN_EPI) { if (wr == 1) PG8_BAR; }
    }
    PG8_WAIT_V(0);
    if constexpr (!ALIGN_EPI) { if (wr == 0) PG8_BAR; }
    PG8_BAR;
#undef PG8_ABASE
#undef PG8_SA
#undef PG8_SB
#undef PG8_STAGE
#undef PG8_LDA
#undef PG8_LDB
#undef PG8_MMA
#undef PG8_WAIT_V
#undef PG8_WAIT_L
#undef PG8_BAR
#undef PG8_SCHED
}
}

#define GAS __attribute__((address_space(1)))
#define LAS __attribute__((address_space(3)))
typedef GAS unsigned gu32;
typedef GAS unsigned long long gu64;
#define RLX_AGENT __ATOMIC_RELAXED, __HIP_MEMORY_SCOPE_AGENT
#define LDS_WAIT() asm volatile("s_waitcnt lgkmcnt(0)" ::: "memory")
#define VM_WAIT() asm volatile("s_waitcnt vmcnt(0)" ::: "memory")

#define XB_TMO      128
#define XB_XCNT(j)  (256  + 64 * (j))
#define XB_XSUB(j)  (1280 + 64 * (j))
#define XB_XGEN(j)  (2304 + 64 * (j))
#define XB_TOP      3328
#define XB_TOPGEN   3392
#define XCD_BAR_WORDS 3456
#define XB_SPIN_CAP (1u << 18)

__device__ __forceinline__ unsigned xb_ld(unsigned* p)              { return __hip_atomic_load(p, __ATOMIC_RELAXED, __HIP_MEMORY_SCOPE_AGENT); }
__device__ __forceinline__ unsigned xb_add(unsigned* p, unsigned v) { return __hip_atomic_fetch_add(p, v, __ATOMIC_RELAXED, __HIP_MEMORY_SCOPE_AGENT); }
__device__ __forceinline__ unsigned xb_xcc_id() { return (unsigned)__builtin_amdgcn_s_getreg((3 << 11) | 20) & 0xFu; }
#define XB_SPIN(cond, bar) do { unsigned _sp = 0; while (cond) { __builtin_amdgcn_s_sleep(1); \
    if ((++_sp & 255u) == 0u) { if (xb_ld(&(bar)[XB_TMO])) break; if (_sp > XB_SPIN_CAP) { atomicAdd(&(bar)[XB_TMO], 1u); break; } } } } while (0)

struct XcdBarrier {
    unsigned* bar; unsigned x;
    volatile LAS unsigned* st;
};

__device__ __forceinline__ XcdBarrier xcd_barrier_post(unsigned* bar, volatile LAS unsigned* st, bool leader) {
    XcdBarrier b; b.bar = bar; b.x = xb_xcc_id(); b.st = st;
    if (leader) (void)xb_add(&bar[XB_XCNT(b.x)], 1u);
    return b;
}
__device__ __forceinline__ void xcd_barrier_complete(unsigned* bar, unsigned x, unsigned& nloc, unsigned& nx) {
    const unsigned G = gridDim.x * gridDim.y * gridDim.z;
    unsigned sum, cnt, mine, sp = 0u;
    for (;;) {
        sum = 0u; cnt = 0u; mine = 0u;
#pragma unroll
        for (unsigned j = 0; j < 16; ++j) { const unsigned c = xb_ld(&bar[XB_XCNT(j)]); sum += c; cnt += (c > 0u) ? 1u : 0u; mine = (j == x) ? c : mine; }
        if (sum == G) break;
        __builtin_amdgcn_s_sleep(1);
        if ((++sp & 255u) == 0u) { if (xb_ld(&bar[XB_TMO])) break; if (sp > XB_SPIN_CAP) { atomicAdd(&bar[XB_TMO], 1u); break; } }
    }
    nloc = mine > 0u ? mine : 1u; nx = cnt > 0u ? cnt : 1u;
}

__device__ __forceinline__ void xcd_barrier(const XcdBarrier& b, int wave_) {
    int lane_; asm volatile("v_mbcnt_lo_u32_b32 %0, -1, 0\n\tv_mbcnt_hi_u32_b32 %0, -1, %0" : "=v"(lane_));
    asm volatile("s_waitcnt vmcnt(0)" ::: "memory");
    __syncthreads();
    if (wave_ == 0 && lane_ == 0) {
        unsigned* bar = b.bar;
        __builtin_amdgcn_s_waitcnt(0);
        unsigned nloc = b.st[0], nx = b.st[1];
        if (nloc == 0u) { xcd_barrier_complete(bar, b.x, nloc, nx); b.st[0] = nloc; b.st[1] = nx; }
        const unsigned old = xb_add(&bar[XB_XSUB(b.x)], 1u);
        const unsigned gen = old / nloc;
        if (old + 1u == (gen + 1u) * nloc) {
            __builtin_amdgcn_fence(__ATOMIC_RELEASE, "agent");
            asm volatile("s_waitcnt vmcnt(0)" ::: "memory");
            const unsigned og = xb_add(&bar[XB_TOP], 1u);
            const unsigned tg = og / nx;
            if (og + 1u == (tg + 1u) * nx) xb_add(&bar[XB_TOPGEN], 1u);
            else XB_SPIN(xb_ld(&bar[XB_TOPGEN]) == tg, bar);
            __builtin_amdgcn_fence(__ATOMIC_ACQUIRE, "agent");
            xb_add(&bar[XB_XGEN(b.x)], 1u);
            asm volatile("s_waitcnt vmcnt(0)" ::: "memory");
        } else {
            XB_SPIN(xb_ld(&bar[XB_XGEN(b.x)]) == gen, bar);
            __builtin_amdgcn_fence(__ATOMIC_ACQUIRE, "agent");
            asm volatile("s_waitcnt vmcnt(0)" ::: "memory");
        }
    }
    __syncthreads();
}

__host__ __device__ inline int w1_src_col(int n) { const int pn = n >> 8; if (pn >= 18) { const int sg_ = n & 255; return 4608 + ((sg_ >> 7) ? 1024 : 0) + 128 * (pn - 18) + (sg_ & 127); }
    const bool head = (pn < 4) || (pn >= 6 && pn < 10); if (!head) return n; const int s = n & 255, bj = s >> 7, wc = (s >> 5) & 3, rho = s & 31; return (pn << 8) + 64 * wc + 32 * bj + rho; }
__host__ __device__ inline int w2_src_col(int n) { const int pn = n >> 8, s = n & 255, bj = s >> 7, j = s & 127; return (bj ? DFF : 0) + 128 * pn + j; }
__device__ __forceinline__ float wave_sum(float v) {
#pragma unroll
    for (int o = 1; o < 64; o <<= 1) v += __shfl_xor(v, o);
    return v;
}
__device__ __forceinline__ unsigned pk2(float lo, float hi) { return (unsigned)f2bf(lo) | ((unsigned)f2bf(hi) << 16); }
__device__ __forceinline__ void p0_transpose_item(const float* W, const float* gain, int K, int N, bf16_t* WT, int ldw, int mode, LAS float* scr, int item, int lane) {
    const int nblk = N / 32, kb = item / nblk, nb = item % nblk, k0 = 64 * kb, n0 = 32 * nb;
    const int s0 = mode == 1 ? w1_src_col(n0) : mode == 2 ? w2_src_col(n0) : n0;
    f32x4 wv[8];
#pragma unroll
    for (int i = 0; i < 8; ++i) { const int kk = 8 * i + (lane >> 3); wv[i] = *(const f32x4*)(W + (size_t)(k0 + kk) * N + s0 + 4 * (lane & 7)); }
#pragma unroll
    for (int i = 0; i < 8; ++i) { const int kk = 8 * i + (lane >> 3); const float gk = gain ? gain[k0 + kk] : 1.f; LAS float* d = scr + kk * 33 + 4 * (lane & 7);
        d[0] = wv[i][0] * gk; d[1] = wv[i][1] * gk; d[2] = wv[i][2] * gk; d[3] = wv[i][3] * gk; }
    LDS_WAIT(); asm volatile("" ::: "memory");
    const int c = lane & 7;
#pragma unroll
    for (int j = 0; j < 4; ++j) { const int n = (lane >> 3) + 8 * j; const LAS float* sp = scr + (8 * c) * 33 + n;
        u32x4 o; o.x = pk2(sp[0 * 33], sp[1 * 33]); o.y = pk2(sp[2 * 33], sp[3 * 33]); o.z = pk2(sp[4 * 33], sp[5 * 33]); o.w = pk2(sp[6 * 33], sp[7 * 33]);
        *(u32x4*)(WT + (size_t)(n0 + n) * ldw + k0 + 8 * c) = o; }
    LDS_WAIT(); asm volatile("" ::: "memory");
}
namespace sba {
typedef float f32x16 __attribute__((ext_vector_type(16)));
typedef short s16x4 __attribute__((ext_vector_type(4)));
typedef short v4i16_t __attribute__((ext_vector_type(4)));
constexpr int VREG = 4096;
constexpr int WAVE_LDS = 4 * VREG;
__device__ __forceinline__ int crow(int r, int hi) { return (r & 3) + 8 * (r >> 2) + 4 * hi; }
__device__ __forceinline__ s16x4 vtr(const LAS unsigned char* p) { return __builtin_bit_cast(s16x4, __builtin_amdgcn_ds_read_tr16_b64_v4i16((LAS v4i16_t*)p)); }

template <bool B> struct BoolC { static constexpr bool value = B; };
__device__ __forceinline__ float smul_(float a, float b) { float r; asm volatile("v_mul_f32 %0, %1, %2" : "=v"(r) : "v"(a), "v"(b)); return r; }
#define SMUL(a_, b_) smul_((a_), (b_))
__device__ __forceinline__ void attn_item(int item, const bf16_t* Q, const bf16_t* Kk, const bf16_t* V, bf16_t* Y, LAS unsigned char* vl, int lane, gu32* ctr, int& nxt_it) {
    const int r32 = lane & 31, hi = lane >> 5;
    const int qb = item & 63, h = (item >> 6) & 7, b = item >> 9;
    const int t0 = qb * 32; const size_t rowbase = (size_t)b * SEQ;
    bf16x8 qf[4];
#pragma unroll
    for (int d0 = 0; d0 < 4; ++d0) qf[d0] = *(const bf16x8*)(Q + (rowbase + t0 + r32) * 512 + h * 64 + d0 * 16 + hi * 8);
    f32x16 o0 = {}, o1 = {};
    float carry = 1.f;
    const int jt = t0 >> 6;
    const int vbase = (4 * hi + ((lane & 15) >> 2)) * 64 + (16 * ((lane >> 4) & 1) + 4 * (lane & 3)) * 2;
    bf16x8 kfA[2][4], kfB[2][4];
#define SBA_LOAD(j_, ib_, kf_) do { const bf16_t* kp_ = Kk + (rowbase + 64 * (j_) + r32) * 512 + h * 64 + hi * 8; const bf16_t* vp_ = V + (rowbase + 64 * (j_) + (lane >> 2)) * 512 + h * 64 + (lane & 3) * 8; \
        _Pragma("unroll") for (int mb_ = 0; mb_ < 2; ++mb_) _Pragma("unroll") for (int d0_ = 0; d0_ < 4; ++d0_) kf_[mb_][d0_] = *(const bf16x8*)(kp_ + (size_t)mb_ * 32 * 512 + d0_ * 16); \
        _Pragma("unroll") for (int mb_ = 0; mb_ < 2; ++mb_) _Pragma("unroll") for (int g_ = 0; g_ < 4; ++g_) \
            __builtin_amdgcn_global_load_lds((const unsigned*)(vp_ + (size_t)g_ * 16 * 512 + mb_ * 32), (LAS unsigned*)(vl + (ib_) * 2 * VREG + mb_ * VREG + g_ * 1024), 16, 0, 0); } while (0)
    int ib = 0;
    SBA_LOAD(jt, 0, kfA);
    auto tile = [&](auto diag_, const int j, bf16x8 (&kf)[2][4], bf16x8 (&kn)[2][4]) -> bool {
        constexpr bool diag = decltype(diag_)::value;
        if (!diag && j == jt - 1) asm volatile("s_waitcnt vmcnt(1)" ::: "memory"); else asm volatile("s_waitcnt vmcnt(0)" ::: "memory");
        f32x16 p0, p1;
        asm("v_mfma_f32_32x32x16_bf16 %0, %1, %2, 0" : "=&v"(p0) : "v"(kf[0][0]), "v"(qf[0]));
        asm("v_mfma_f32_32x32x16_bf16 %0, %1, %2, 0" : "=&v"(p1) : "v"(kf[1][0]), "v"(qf[0]));
#pragma unroll
        for (int d0 = 1; d0 < 4; ++d0) { p0 = __builtin_amdgcn_mfma_f32_32x32x16_bf16(kf[0][d0], qf[d0], p0, 0, 0, 0); p1 = __builtin_amdgcn_mfma_f32_32x32x16_bf16(kf[1][d0], qf[d0], p1, 0, 0, 0); }
        const LAS unsigned char* vcur = vl + ib * 2 * VREG;
        if (j > 0) { SBA_LOAD(j - 1, ib ^ 1, kn); }
        if (diag) { nxt_it = 0; if (lane == 0) nxt_it = (int)__hip_atomic_fetch_add(ctr, 1u, __ATOMIC_RELAXED, __HIP_MEMORY_SCOPE_AGENT); }
        const int qrel = t0 + r32 - 64 * j;
#define PSEL(g_, i_) ((g_) < 4 ? p0[4 * (g_) + (i_)] : p1[4 * ((g_) - 4) + (i_)])
#pragma unroll
        for (int g = 0; g < 8; ++g) {
#pragma unroll
            for (int i = 0; i < 4; ++i) { const int r = 4 * (g & 3) + i; const float sv = g < 4 ? p0[r] : p1[r];
                float e = __builtin_amdgcn_exp2f(sv);
                if (diag) { if (crow(r, hi) + (g < 4 ? 0 : 32) >= qrel) e = 0.f; }
                const float om = __builtin_amdgcn_rcpf(1.f + e);
                if (g < 4) p0[r] = om; else p1[r] = om; } }
        float T[8], ta[8], tb[8];
#pragma unroll
        for (int g = 0; g < 8; ++g) { ta[g] = SMUL(PSEL(g, 0), PSEL(g, 1)); tb[g] = SMUL(PSEL(g, 2), PSEL(g, 3)); }
#pragma unroll
        for (int g = 0; g < 8; ++g) T[g] = SMUL(ta[g], tb[g]);
        float thi_[8], tt[8];
#pragma unroll
        for (int g = 0; g < 8; ++g) { auto rr = __builtin_amdgcn_permlane32_swap(__float_as_uint(T[g]), __float_as_uint(T[g]), false, false);
            thi_[g] = __uint_as_float(rr[1]); tt[g] = SMUL(__uint_as_float(rr[0]), thi_[g]); }
        float base[8]; float R = carry;
#pragma unroll
        for (int g = 7; g >= 0; --g) { const float Rn = SMUL(R, tt[g]); const float rt = SMUL(R, thi_[g]); base[g] = hi ? R : rt; R = Rn; }
        carry = R;
        {   float tq[8], tn[8];
#pragma unroll
            for (int g = 0; g < 8; ++g) tq[g] = base[g];
#pragma unroll
            for (int i = 3; i >= 0; --i) {
#pragma unroll
                for (int g = 0; g < 8; ++g) tn[g] = SMUL(tq[g], PSEL(g, i));
#pragma unroll
                for (int g = 0; g < 8; ++g) { if (g < 4) p0[4 * g + i] = tq[g] - tn[g]; else p1[4 * (g - 4) + i] = tq[g] - tn[g]; tq[g] = tn[g]; } }
        }
#undef PSEL
        bf16x8 pf[4];
#pragma unroll
        for (int s = 0; s < 4; ++s) { u32x4 w;
            if (s < 2) { w.x = cvt_pk_bf16(p0[8 * s], p0[8 * s + 1]); w.y = cvt_pk_bf16(p0[8 * s + 2], p0[8 * s + 3]); w.z = cvt_pk_bf16(p0[8 * s + 4], p0[8 * s + 5]); w.w = cvt_pk_bf16(p0[8 * s + 6], p0[8 * s + 7]); }
            else { const int q = 8 * (s - 2); w.x = cvt_pk_bf16(p1[q], p1[q + 1]); w.y = cvt_pk_bf16(p1[q + 2], p1[q + 3]); w.z = cvt_pk_bf16(p1[q + 4], p1[q + 5]); w.w = cvt_pk_bf16(p1[q + 6], p1[q + 7]); }
            pf[s] = __builtin_bit_cast(bf16x8, w); }
#pragma unroll
        for (int s = 0; s < 4; ++s) {
            const s16x4 a0l = vtr(vcur + vbase + (16 * s) * 64), a0h = vtr(vcur + vbase + (16 * s + 8) * 64);
            const s16x4 a1l = vtr(vcur + VREG + vbase + (16 * s) * 64), a1h = vtr(vcur + VREG + vbase + (16 * s + 8) * 64);
            const bf16x8 A0 = (bf16x8){a0l[0], a0l[1], a0l[2], a0l[3], a0h[0], a0h[1], a0h[2], a0h[3]}, A1 = (bf16x8){a1l[0], a1l[1], a1l[2], a1l[3], a1h[0], a1h[1], a1h[2], a1h[3]};
            o0 = __builtin_amdgcn_mfma_f32_32x32x16_bf16(A0, pf[s], o0, 0, 0, 0); o1 = __builtin_amdgcn_mfma_f32_32x32x16_bf16(A1, pf[s], o1, 0, 0, 0);
        }
        ib ^= 1;
        return __all(carry < 7.8886e-31f);
    };
    if (!tile(BoolC<true>{}, jt, kfA, kfB))
        for (int j = jt - 1; j >= 0; j -= 2) { if (tile(BoolC<false>{}, j, kfB, kfA) || j == 0) break; if (tile(BoolC<false>{}, j - 1, kfA, kfB)) break; }
#undef SBA_LOAD
    bf16_t* yp = Y + (rowbase + t0 + r32) * 512 + h * 64 + 4 * hi;
#pragma unroll
    for (int g = 0; g < 4; ++g) { u32x2 w; w.x = cvt_pk_bf16(o0[4 * g], o0[4 * g + 1]); w.y = cvt_pk_bf16(o0[4 * g + 2], o0[4 * g + 3]); *(u32x2*)(yp + 8 * g) = w;
                                  u32x2 x; x.x = cvt_pk_bf16(o1[4 * g], o1[4 * g + 1]); x.y = cvt_pk_bf16(o1[4 * g + 2], o1[4 * g + 3]); *(u32x2*)(yp + 32 + 8 * g) = x; }
}
}

namespace ret {
typedef float f32x16 __attribute__((ext_vector_type(16)));
typedef short s16x4 __attribute__((ext_vector_type(4)));
typedef short v4i16_t __attribute__((ext_vector_type(4)));
constexpr int RSTR = 4096 + 32;
constexpr int KT_BYTES = 16640, VT_BYTES = 33280, SB_PITCH = 144, SB_BYTES = 128 * SB_PITCH;
constexpr int OFF_KT = 0, OFF_VT = 2 * KT_BYTES, OFF_SB = OFF_VT + 2 * VT_BYTES, OFF_G = OFF_SB + SB_BYTES, OFF_X = OFF_G + 512, LDS_TOTAL = OFF_X + 1024;
constexpr int OFF_Q = 132096, Q_BYTES = 128 * SB_PITCH;
__device__ __forceinline__ int crow(int r, int hi) { return (r & 3) + 8 * (r >> 2) + 4 * hi; }
__device__ __forceinline__ s16x4 vtr(const LAS unsigned char* p) { return __builtin_bit_cast(s16x4, __builtin_amdgcn_ds_read_tr16_b64_v4i16((LAS v4i16_t*)p)); }
#define RET_BAR() do { asm volatile("s_waitcnt lgkmcnt(0)" ::: "memory"); __builtin_amdgcn_s_barrier(); asm volatile("" ::: "memory"); } while (0)
#define RET_PK(lo_, hi_) ((bf16x8){lo_[0], lo_[1], lo_[2], lo_[3], hi_[0], hi_[1], hi_[2], hi_[3]})

__device__ __forceinline__ void ret_seq(int bh, const bf16_t* Qr, const bf16_t* Kr, const bf16_t* Vr, const bf16_t* SG, const float* gain, bf16_t* Y, LAS unsigned char* L, int tid, gu32* prog) {
    const int lane = tid & 63, w = __builtin_amdgcn_readfirstlane(tid >> 6), r32 = lane & 31, hi = lane >> 5, g16 = (lane >> 4) & 1, i16 = lane & 15;
    const int rb = w < 4 ? (w >> 1) : 3 - ((w >> 1) & 1), eh = w & 1;
    const int b = bh >> 3, h = bh & 7; const size_t rowbase = (size_t)b * SEQ, hmbase = (size_t)bh * SEQ;
    const float gmm = 1.f - exp2f(-5.f - (float)h), lg = log2f(gmm); const float gC = exp2f(lg * 128.f), gC1 = exp2f(lg * 127.f);
    f32x16 S = {};
    u32x4 kreg[2], vreg[4], qreg[2];
#define RET_LOAD(n_) do { const size_t r0_ = hmbase + (size_t)(n_) * 128;     \
        _Pragma("unroll") for (int i_ = 0; i_ < 2; ++i_) { const int c_ = tid + 512 * i_; kreg[i_] = *(const u32x4*)(Kr + (r0_ + (c_ >> 3)) * 64 + (c_ & 7) * 8); qreg[i_] = *(const u32x4*)(Qr + (r0_ + (c_ >> 3)) * 64 + (c_ & 7) * 8); } \
        _Pragma("unroll") for (int i_ = 0; i_ < 4; ++i_) { const int c_ = tid + 512 * i_; vreg[i_] = *(const u32x4*)(Vr + (r0_ + (c_ >> 4)) * 128 + (c_ & 15) * 8); } } while (0)
#define RET_WRITE(buf_) do { \
        _Pragma("unroll") for (int i_ = 0; i_ < 2; ++i_) { const int c_ = tid + 512 * i_, key_ = c_ >> 3, part_ = c_ & 7; *(LAS u32x4*)(L + OFF_KT + (buf_) * KT_BYTES + (part_ >> 1) * RSTR + key_ * 32 + (part_ & 1) * 16) = kreg[i_]; \
            *(LAS u32x4*)(L + OFF_Q + key_ * SB_PITCH + part_ * 16) = qreg[i_]; } \
        _Pragma("unroll") for (int i_ = 0; i_ < 4; ++i_) { const int c_ = tid + 512 * i_, key_ = c_ >> 4, part_ = c_ & 15; *(LAS u32x4*)(L + OFF_VT + (buf_) * VT_BYTES + (part_ >> 1) * RSTR + key_ * 32 + (part_ & 1) * 16) = vreg[i_]; } } while (0)
    RET_LOAD(0);
    for (int i = tid; i < SB_BYTES / 4; i += 512) ((LAS unsigned*)(L + OFF_SB))[i] = 0u;
    if (tid < 128) ((LAS float*)(L + OFF_G))[tid] = gain[h * 128 + tid];
    RET_WRITE(0);
    const int troff = (4 * hi + (i16 >> 2)) * 32 + (i16 & 3) * 8;
    const size_t qrow0 = rowbase + 32 * rb + r32;
    RET_BAR();
    for (int n = 0; n < 16; ++n) {
        const int buf = n & 1; const LAS unsigned char* Kt = L + OFF_KT + buf * KT_BYTES; const LAS unsigned char* Vt = L + OFF_VT + buf * VT_BYTES;
        const size_t qrow = qrow0 + (size_t)n * 128;
        if (tid == 0) __hip_atomic_store(prog, (unsigned)(n + 1), __ATOMIC_RELAXED, __HIP_MEMORY_SCOPE_AGENT);
        u32x2 sgv[8];
#pragma unroll
        for (int q = 0; q < 8; ++q) sgv[q] = *(const u32x2*)(SG + (hmbase + (size_t)n * 128 + 32 * rb + r32) * 128 + 64 * eh + 32 * (q >> 2) + 8 * (q & 3) + 4 * hi);
        bf16x8 qf[4];
#pragma unroll
        for (int ks = 0; ks < 4; ++ks) qf[ks] = *(const LAS bf16x8*)(L + OFF_Q + (32 * rb + r32) * SB_PITCH + (16 * ks + 8 * hi) * 2);
        const int nn = n < 15 ? n + 1 : 15;
        RET_LOAD(nn);
        f32x16 y0 = {}, y1 = {};
#pragma unroll
        for (int kb = 0; kb < 4; ++kb) if (kb <= rb) {
            bf16x8 ka[4];
#pragma unroll
            for (int ks = 0; ks < 4; ++ks) ka[ks] = *(const LAS bf16x8*)(Kt + ks * RSTR + (32 * kb + r32) * 32 + hi * 16);
            s16x4 vl0[2][2], vh0[2][2];
#pragma unroll
            for (int s = 0; s < 2; ++s)
#pragma unroll
                for (int eb = 0; eb < 2; ++eb) { const LAS unsigned char* vp = Vt + (4 * eh + 2 * eb + g16) * RSTR + (32 * kb + 16 * s) * 32 + troff; vl0[s][eb] = vtr(vp); vh0[s][eb] = vtr(vp + 8 * 32); }
            __builtin_amdgcn_sched_barrier(0);
            f32x16 in = {};
#pragma unroll
            for (int ks = 0; ks < 4; ++ks) in = __builtin_amdgcn_mfma_f32_32x32x16_bf16(ka[ks], qf[ks], in, 0, 0, 0);
            if (kb == rb) {
#pragma unroll
                for (int r = 0; r < 16; ++r) if (crow(r, hi) > r32) in[r] = 0.f; }
#pragma unroll
            for (int s = 0; s < 2; ++s) { u32x4 pw; pw.x = cvt_pk_bf16(in[8 * s], in[8 * s + 1]); pw.y = cvt_pk_bf16(in[8 * s + 2], in[8 * s + 3]); pw.z = cvt_pk_bf16(in[8 * s + 4], in[8 * s + 5]); pw.w = cvt_pk_bf16(in[8 * s + 6], in[8 * s + 7]);
                const bf16x8 pf = __builtin_bit_cast(bf16x8, pw);
                y0 = __builtin_amdgcn_mfma_f32_32x32x16_bf16(RET_PK(vl0[s][0], vh0[s][0]), pf, y0, 0, 0, 0);
                y1 = __builtin_amdgcn_mfma_f32_32x32x16_bf16(RET_PK(vl0[s][1], vh0[s][1]), pf, y1, 0, 0, 0); }
            __builtin_amdgcn_sched_barrier(0);
        }
        { bf16x8 sa[2][4];
#pragma unroll
          for (int eb = 0; eb < 2; ++eb)
#pragma unroll
              for (int ks = 0; ks < 4; ++ks) sa[eb][ks] = *(const LAS bf16x8*)(L + OFF_SB + (64 * eh + 32 * eb + r32) * SB_PITCH + (16 * ks + 8 * hi) * 2);
          __builtin_amdgcn_sched_barrier(0);
#pragma unroll
          for (int ks = 0; ks < 4; ++ks) { y0 = __builtin_amdgcn_mfma_f32_32x32x16_bf16(sa[0][ks], qf[ks], y0, 0, 0, 0); y1 = __builtin_amdgcn_mfma_f32_32x32x16_bf16(sa[1][ks], qf[ks], y1, 0, 0, 0); }
          __builtin_amdgcn_sched_barrier(0); }
        { float ss = 0.f;
#pragma unroll
          for (int r = 0; r < 16; ++r) ss += y0[r] * y0[r] + y1[r] * y1[r];
          auto rr = __builtin_amdgcn_permlane32_swap(__float_as_uint(ss), __float_as_uint(ss), false, false); ss = __uint_as_float(rr[0]) + __uint_as_float(rr[1]);
          if (hi == 0) ((LAS float*)(L + OFF_X))[(32 * rb + r32) * 2 + eh] = ss; }
        f32x16 U = {};
#pragma unroll
        for (int s2 = 0; s2 < 4; ++s2) {
            s16x4 al[2], ah[2], bl[2], bh_[2];
#pragma unroll
            for (int q = 0; q < 2; ++q) { const int s = 2 * s2 + q; const LAS unsigned char* ap = Vt + (2 * (w >> 1) + g16) * RSTR + (16 * s) * 32 + troff; const LAS unsigned char* bp = Kt + (2 * (w & 1) + g16) * RSTR + (16 * s) * 32 + troff;
                al[q] = vtr(ap); ah[q] = vtr(ap + 8 * 32); bl[q] = vtr(bp); bh_[q] = vtr(bp + 8 * 32); }
            __builtin_amdgcn_sched_barrier(0);
#pragma unroll
            for (int q = 0; q < 2; ++q) U = __builtin_amdgcn_mfma_f32_32x32x16_bf16(RET_PK(al[q], ah[q]), RET_PK(bl[q], bh_[q]), U, 0, 0, 0);
            __builtin_amdgcn_sched_barrier(0);
        }
        RET_BAR();
        RET_WRITE(buf ^ 1);
        { const float tot = ((const LAS float*)(L + OFF_X))[(32 * rb + r32) * 2] + ((const LAS float*)(L + OFF_X))[(32 * rb + r32) * 2 + 1];
          const float rs = 1.0f / sqrtf(tot * (1.f / 128.f) + EPS);
#pragma unroll
          for (int q = 0; q < 8; ++q) { const int eb = q >> 2, g = q & 3, e0 = 64 * eh + 32 * eb + 8 * g + 4 * hi; const u32x2 sg = sgv[q];
              const f32x4 gv = *(const LAS f32x4*)(L + OFF_G + e0 * 4);
              float o0, o1, o2, o3;
              if (eb == 0) { o0 = y0[4 * g]; o1 = y0[4 * g + 1]; o2 = y0[4 * g + 2]; o3 = y0[4 * g + 3]; } else { o0 = y1[4 * g]; o1 = y1[4 * g + 1]; o2 = y1[4 * g + 2]; o3 = y1[4 * g + 3]; }
              u32x2 wv; wv.x = cvt_pk_bf16(o0 * gv[0] * rs * __builtin_bit_cast(float, sg.x << 16), o1 * gv[1] * rs * __builtin_bit_cast(float, sg.x & 0xffff0000u));
              wv.y = cvt_pk_bf16(o2 * gv[2] * rs * __builtin_bit_cast(float, sg.y << 16), o3 * gv[3] * rs * __builtin_bit_cast(float, sg.y & 0xffff0000u));
              *(u32x2*)(Y + qrow * 1024 + h * 128 + e0) = wv; } }
#pragma unroll
        for (int r = 0; r < 16; ++r) { S[r] = S[r] * gC + U[r] * gC1;
            *(LAS bf16_t*)(L + OFF_SB + (32 * (w >> 1) + crow(r, hi)) * SB_PITCH + (32 * (w & 1) + r32) * 2) = f2bf(S[r] * gmm); }
        RET_BAR();
    }
#undef RET_LOAD
#undef RET_WRITE
}
}

constexpr int RING_OFF = 0, RING_BYTES = 131072;
constexpr int LDSCTL_OFF = RING_BYTES, MISC_OFF = LDSCTL_OFF + 320;
constexpr int EPI_OFF = RING_BYTES + 1024;
constexpr int LDS_BYTES = 160 * 1024;
constexpr int NWAVES = 8;
constexpr int CW_TMO = 0, CW_CODE = 1, CW_BAR = 4096, CW_ATT = 49152;
constexpr int MAX_BAR_REGIONS = 12;
constexpr int CW_PROG = 56320;
static_assert((CW_PROG + 2 * 256 * 16) * 4 <= (int)CTL_ZERO_BYTES, "progress words inside the memset region");
static_assert(CW_BAR + MAX_BAR_REGIONS * XCD_BAR_WORDS <= CW_ATT && (CW_ATT + MAX_BAR_REGIONS * 8 * 64) * 4 <= (int)CTL_ZERO_BYTES, "CTL words inside the memset region");

struct Args { const float* in[18]; float* out; unsigned char* ws; int ph_lo, ph_hi, li, pad; };

__global__ void __launch_bounds__(NWAVES * 64, 2) mk_fwd(Args args) {
    extern __shared__ __attribute__((aligned(16))) unsigned char lds_raw[];
    LAS unsigned char* lds = (LAS unsigned char*)lds_raw;
    volatile LAS unsigned* MISC = (volatile LAS unsigned*)(lds + MISC_OFF);
    const int wave = __builtin_amdgcn_readfirstlane((int)threadIdx.x >> 6);
#define FRESH_LANE() ({ int l_; asm volatile("v_mbcnt_lo_u32_b32 %0, -1, 0\n\tv_mbcnt_hi_u32_b32 %0, -1, %0" : "=v"(l_)); l_; })
    const int G = gridDim.x;
    unsigned char* ws = args.ws;
    gu32* ctl = (gu32*)(ws + WS_CTL);
    for (int u = (int)threadIdx.x; u < 1024 / 4; u += NWAVES * 64) ((LAS unsigned*)(lds + LDSCTL_OFF))[u] = 0u;
    __syncthreads();
    XcdBarrier bar = xcd_barrier_post((unsigned*)(ctl + CW_BAR) + args.li * XCD_BAR_WORDS, MISC + 8, threadIdx.x == 0);
    const int lo = args.ph_lo, hi = args.ph_hi;
#ifndef PHASE_MASK
#define PHASE_MASK 0x1ff
#endif
#define IN(k) (((PHASE_MASK >> (k)) & 1) && lo <= (k) && (k) < hi)
#define BOTH(k) (IN(k) && IN((k) + 1))
    float* out = args.out;
    const float* x = args.in[0];

#ifdef VPROBE
    {
        typedef float f2_ __attribute__((ext_vector_type(2)));
        f2_ r[16]; const float kk = 1.0000001f; const f2_ k2 = {kk, kk};
#pragma unroll
        for (int j = 0; j < 16; ++j) { r[j][0] = (float)(threadIdx.x + j); r[j][1] = (float)(threadIdx.x + 2 * j); }
        for (int it = 0; it < 20000; ++it) {
#pragma unroll
            for (int j = 0; j < 16; ++j) {
#if VPROBE == 1
                asm volatile("v_pk_mul_f32 %0, %0, %1" : "+v"(r[j]) : "v"(k2));
#elif VPROBE == 2
                asm volatile("v_mul_f32 %0, %0, %1" : "+v"(r[j][0]) : "v"(kk)); asm volatile("v_mul_f32 %0, %0, %1" : "+v"(r[j][1]) : "v"(kk));
#elif VPROBE == 3
                asm volatile("v_pk_fma_f32 %0, %0, %1, %1" : "+v"(r[j]) : "v"(k2));
#elif VPROBE == 4
                asm volatile("v_exp_f32 %0, %0" : "+v"(r[j][0])); asm volatile("v_rcp_f32 %0, %0" : "+v"(r[j][1]));
#endif
            }
        }
        float s = 0.f;
#pragma unroll
        for (int j = 0; j < 16; ++j) s += r[j][0] + r[j][1];
        if (s == 12345.678f) args.out[0] = s;
    }
#endif
    if (IN(0)) {
        const int lane = FRESH_LANE(), tid = wave * 64 + lane;
        LAS float* scr = (LAS float*)(lds + RING_OFF + wave * 16384);
        const int gw = (int)blockIdx.x * NWAVES + wave, NGW = G * NWAVES;
        constexpr int I1 = (DM / 64) * (DIN / 32), IA = (512 / 64) * (DM / 32), IB = (DM / 64) * (DM / 32), IO = IB, I2 = (DM / 64) * (2 * DFF / 32), I3 = (DFF / 64) * (DM / 32), IG = IB, IP = (PLE / 64) * (DM / 32);
        constexpr int NITEMS = I1 + IA + IB + IO + I2 + I3 + IG + IP;
        for (int it = gw; it < NITEMS; it += NGW) {
            int r = it;
            if (r < I1) { p0_transpose_item(args.in[3], args.in[2], DM, DIN, (bf16_t*)(ws + WS_W1), DM, 1, scr, r, lane); continue; } r -= I1;
            if (r < IA) { p0_transpose_item(args.in[7], nullptr, 512, DM, (bf16_t*)(ws + WS_WAB), 1536, 0, scr, r, lane); continue; } r -= IA;
            if (r < IB) { p0_transpose_item(args.in[8], nullptr, DM, DM, (bf16_t*)(ws + WS_WAB) + 512, 1536, 0, scr, r, lane); continue; } r -= IB;
            if (r < IO) { p0_transpose_item(args.in[9], nullptr, DM, DM, (bf16_t*)(ws + WS_WO), DM, 0, scr, r, lane); continue; } r -= IO;
            if (r < I2) { p0_transpose_item(args.in[11], args.in[10], DM, 2 * DFF, (bf16_t*)(ws + WS_W2), DM, 2, scr, r, lane); continue; } r -= I2;
            if (r < I3) { p0_transpose_item(args.in[14], nullptr, DFF, DM, (bf16_t*)(ws + WS_W3), DFF, 0, scr, r, lane); continue; } r -= I3;
            if (r < IG) { p0_transpose_item(args.in[16], args.in[15], DM, DM, (bf16_t*)(ws + WS_WPG), DM, 0, scr, r, lane); continue; } r -= IG;
            p0_transpose_item(args.in[17], nullptr, PLE, DM, (bf16_t*)(ws + WS_WPP), PLE, 0, scr, r, lane);
        }
        for (int m0 = gw * 4; m0 < M; m0 += NGW * 4) {
            f32x4 v[4][4];
#pragma unroll
            for (int r = 0; r < 4; ++r) { const f32x4* xr = (const f32x4*)(x + (size_t)(m0 + r) * DM) + lane;
#pragma unroll
                for (int j = 0; j < 4; ++j) v[r][j] = xr[64 * j]; }
#pragma unroll
            for (int r = 0; r < 4; ++r) { float ss = 0.f;
#pragma unroll
                for (int j = 0; j < 4; ++j) ss += (v[r][j][0] * v[r][j][0] + v[r][j][1] * v[r][j][1]) + (v[r][j][2] * v[r][j][2] + v[r][j][3] * v[r][j][3]);
                ss = wave_sum(ss);
                if (lane == 0) ((float*)(ws + WS_RSTD0))[m0 + r] = 1.0f / sqrtf(ss * (1.f / DM) + EPS);
                u32x2* o8 = (u32x2*)((bf16_t*)out + (size_t)(m0 + r) * DM) + lane;
#pragma unroll
                for (int j = 0; j < 4; ++j) { u32x2 w; w.x = pk2(v[r][j][0], v[r][j][1]); w.y = pk2(v[r][j][2], v[r][j][3]); o8[64 * j] = w; } }
        }
        { const f32x4* p4 = (const f32x4*)args.in[1]; u32x2* o = (u32x2*)(ws + WS_PB);
          const int T = G * NWAVES * 64;
          for (int i = (int)blockIdx.x * (NWAVES * 64) + tid; i < M * PLE / 4; i += 4 * T) { f32x4 v[4];
#pragma unroll
              for (int q = 0; q < 4; ++q) v[q] = p4[i + q * T];
#pragma unroll
              for (int q = 0; q < 4; ++q) { u32x2 w; w.x = pk2(v[q][0], v[q][1]); w.y = pk2(v[q][2], v[q][3]); o[i + q * T] = w; } } }
        { float* rope = (float*)(ws + WS_ROPE);
          for (int i = (int)blockIdx.x * (NWAVES * 64) + tid; i < SEQ * 32; i += G * NWAVES * 64) { const int t = i >> 5, j = i & 31;
              const float inv = powf(10000.f, -(float)j * (2.0f / 64.f)); float sn, cs; sincosf((float)t * inv, &sn, &cs); rope[i] = cs; rope[SEQ * 32 + i] = sn; } }
        if (BOTH(0)) xcd_barrier(bar, wave);
    }
    if (IN(1)) {
        { pg8::Gemm g{(const bf16_t*)out  , (const bf16_t*)(ws + WS_W1) + (size_t)18 * 256 * DM, M, 8 * 256, DM}; pg8::StaticOrder S; S.init(M, 8 * 256, G, (int)blockIdx.x); S.ntk = DM / 64;
          pg8::EpProj E{18, 0, (const float*)(ws + WS_RSTD0), ws, args.in[4], args.in[5], (const float*)(ws + WS_ROPE)};
          pg8::gemm_phase<pg8::EpProj, pg8::StaticOrder, true, true>(lds + RING_OFF, g, S, E, wave); }
        { pg8::Gemm g{(const bf16_t*)out, (const bf16_t*)(ws + WS_W1), M, 18 * 256, DM}; pg8::StaticOrder S; S.init(M, 18 * 256, G, (int)blockIdx.x); S.ntk = DM / 64;
          pg8::EpProj E{0, 0, (const float*)(ws + WS_RSTD0), ws, args.in[4], args.in[5], (const float*)(ws + WS_ROPE)};
          pg8::gemm_phase<pg8::EpProj, pg8::StaticOrder, true, true>(lds + RING_OFF, g, S, E, wave); }
        if (BOTH(1)) xcd_barrier(bar, wave);
    }
    if (IN(2)) {
        const bf16_t* Q = (const bf16_t*)(ws + WS_QSB); const bf16_t* Kk = (const bf16_t*)(ws + WS_KSB); const bf16_t* V = (const bf16_t*)(ws + WS_VSB);
        bf16_t* Ysb = (bf16_t*)(ws + WS_QSB);
        bf16_t* Yr = (bf16_t*)out + (size_t)M * DM;
        if (((blockIdx.x >> 3) & 1) == 0 && !(args.pad & 4)) {
            const int bh = ((int)blockIdx.x >> 4) * 8 + ((int)blockIdx.x & 7);
            if (bh < NB * 8) ret::ret_seq(bh, (const bf16_t*)(ws + WS_QR), (const bf16_t*)(ws + WS_KR), (const bf16_t*)(ws + WS_VR), (const bf16_t*)(ws + WS_SGR), args.in[6], Yr, lds + RING_OFF, wave * 64 + FRESH_LANE(), ctl + CW_PROG + (args.li & 1) * 4096 + (int)blockIdx.x * 16);
        }
        if (!(args.pad & 8)) {
            const int lane = FRESH_LANE();
            LAS unsigned char* vl = lds + RING_OFF + wave * sba::WAVE_LDS;
            const int shard = (int)blockIdx.x & 7; gu32* ctr = ctl + CW_ATT + (args.li * 8 + shard) * 64;
            if (wave == 7 && (((blockIdx.x >> 3) & 1) == 1) && !(args.pad & 4)) {
                const int pbh = ((int)blockIdx.x >> 4) * 8 + ((int)blockIdx.x & 7);
                gu32* pprog = ctl + CW_PROG + (args.li & 1) * 4096 + ((int)blockIdx.x - 8) * 16;
                LAS unsigned* scr = (LAS unsigned*)(lds + LDSCTL_OFF + 512);
                int c = 0;
                for (int spin = 0; c < 16 && spin < 400000 && pbh < NB * 8; ++spin) {
                    unsigned pg = 0; if (lane == 0) pg = __hip_atomic_load(pprog, __ATOMIC_RELAXED, __HIP_MEMORY_SCOPE_AGENT);
                    pg = (unsigned)__builtin_amdgcn_readfirstlane((int)pg);
                    if (c > (int)pg + 1) { __builtin_amdgcn_s_sleep(16); continue; }
                    const size_t r0 = (size_t)pbh * SEQ + (size_t)c * 128;
                    const char* kq[2] = {(const char*)((const bf16_t*)(ws + WS_KR) + r0 * 64), (const char*)((const bf16_t*)(ws + WS_QR) + r0 * 64)};
                    const char* vs[2] = {(const char*)((const bf16_t*)(ws + WS_VR) + r0 * 128), (const char*)((const bf16_t*)(ws + WS_SGR) + r0 * 128)};
#pragma unroll
                    for (int i = 0; i < 4; ++i) __builtin_amdgcn_global_load_lds((const unsigned*)(kq[i >> 1] + ((i & 1) * 64 + lane) * 128), scr, 4, 0, 0);
#pragma unroll
                    for (int i = 0; i < 8; ++i) __builtin_amdgcn_global_load_lds((const unsigned*)(vs[i >> 2] + ((i & 3) * 64 + lane) * 128), scr, 4, 0, 0);
                    asm volatile("s_waitcnt vmcnt(0)" ::: "memory");
                    ++c;
                }
            }
            int nxt_it = -1;
            for (;;) {
                int it2 = nxt_it; if (it2 < 0) { if (lane == 0) it2 = (int)__hip_atomic_fetch_add(ctr, 1u, __ATOMIC_RELAXED, __HIP_MEMORY_SCOPE_AGENT); }
                it2 = __builtin_amdgcn_readfirstlane(it2);
                if (it2 >= 1024) break;
                sba::attn_item(shard * 1024 + it2, Q, Kk, V, Ysb, vl, lane, ctr, nxt_it);
            }
            __syncthreads();
        }
        if (BOTH(2)) xcd_barrier(bar, wave);
    }
    if (IN(3)) {
        pg8::Gemm g{(const bf16_t*)out + (size_t)M * DM  , (const bf16_t*)(ws + WS_WAB), M, DM, 1536, DM, (const bf16_t*)(ws + WS_QSB)  , 512, 0}; pg8::PairOrder S; S.base.init(M, DM, G, (int)blockIdx.x); S.base.ntk = 0;
        pg8::EpMerged E{0, 0, (const bf16_t*)(ws + WS_SA), (bf16_t*)(ws + WS_SB)};
        pg8::gemm_phase<pg8::EpMerged, pg8::PairOrder, true, true, true>(lds + RING_OFF, g, S, E, wave);
        if (BOTH(3)) xcd_barrier(bar, wave);
    }
    if (IN(4)) {
        if (!(args.pad & 2)) { pg8::Gemm g{(const bf16_t*)(ws + WS_MERGED), (const bf16_t*)(ws + WS_WO), M, DM, DM}; pg8::StaticOrder S; S.init(M, DM, G, (int)blockIdx.x); S.ntk = DM / 64;
          pg8::EpResid<true> E{0, 0, (const void*)out  , (bf16_t*)(ws + WS_X1B), (float*)(ws + WS_PART1)};
          pg8::gemm_phase<pg8::EpResid<true>, pg8::StaticOrder, true, true>(lds + RING_OFF, g, S, E, wave); }
        if (BOTH(4)) xcd_barrier(bar, wave);
    }
    if (IN(5)) {
        pg8::Gemm g{(const bf16_t*)(ws + WS_X1B), (const bf16_t*)(ws + WS_W2), M, 2 * DFF, DM}; pg8::StaticOrder S; S.init(M, 2 * DFF, G, (int)blockIdx.x); S.ntk = DM / 64;
        pg8::Unit u0; (void)S.next(0, u0);
        {
            const int tid = wave * 64 + FRESH_LANE(); LAS float* tab = (LAS float*)(lds + EPI_OFF + 4096); pg8::Unit fu; int prev_pm = -1, slot = 0;
            for (int i = 0; S.next(i, fu); ++i) { if (fu.pm == prev_pm) continue; prev_pm = fu.pm; slot = (fu.pm - u0.pm) / pg8::WGM;
                if (tid < 256 && slot < 8) tab[slot * 256 + tid] = rstd_part((const float*)(ws + WS_PART1), fu.pm * 256 + tid); }
            __syncthreads();
        }
        pg8::EpUp E{u0.pm, pg8::WGM, (const float*)(ws + WS_PART1), args.in[12], args.in[13], (bf16_t*)(ws + WS_ACT), (float*)(ws + WS_HALO)};
        pg8::gemm_phase<pg8::EpUp, pg8::StaticOrder, true, true>(lds + RING_OFF, g, S, E, wave);
        if (BOTH(5)) xcd_barrier(bar, wave);
    }
    if (IN(7)) {
        pg8::Gemm g{(const bf16_t*)(ws + WS_ACT), (const bf16_t*)(ws + WS_W3), M, DM, DFF}; pg8::StaticOrder S; S.init(M, DM, G, (int)blockIdx.x); S.ntk = DFF / 64;
        {   const int tid = wave * 64 + FRESH_LANE();
            const float* halo = (const float*)(ws + WS_HALO); const float* cw = args.in[12]; const float* cb = args.in[13]; bf16_t* act = (bf16_t*)(ws + WS_ACT);
            pg8::Unit fu; int pms[2] = {-1, -1}; int npm = 0;
            for (int i = 0; S.next(i, fu); ++i) { if (npm > 0 && fu.pm == pms[npm - 1]) continue; if (npm < 2) pms[npm++] = fu.pm; }
            constexpr int C4 = DFF / 4;
            const int nitems = npm * 2 * C4;
#pragma unroll 1
            for (int base = tid; base < nitems; base += 2 * NWAVES * 64) {
                f32x4 a0v[2], u0v[2], l0v[2], l1v[2], f0v[2], w0v[2], w1v[2], w2v[2], bbv[2]; int pmv[2], jv[2], chv[2]; bool ok[2];
#pragma unroll
                for (int q = 0; q < 2; ++q) { const int idx = base + q * NWAVES * 64; ok[q] = idx < nitems; const int id = ok[q] ? idx : 0;
                    const int slot = id / (2 * C4), rem = id % (2 * C4), j = rem / C4, ch = 4 * (rem % C4), pm = slot ? pms[1] : pms[0]; pmv[q] = pm; jv[q] = j; chv[q] = ch;
                    const int pmp = (pm & 7) ? pm - 1 : pm;
                    a0v[q] = *(const f32x4*)(halo + HALO_ELEMS + ((size_t)pm * 2 + j) * DFF + ch); u0v[q] = *(const f32x4*)(halo + 2 * HALO_ELEMS + ((size_t)pm * 2 + j) * DFF + ch);
                    f0v[q] = *(const f32x4*)(halo + HALO_ELEMS + ((size_t)pm * 2) * DFF + ch);
                    l0v[q] = *(const f32x4*)(halo + ((size_t)pmp * 2) * DFF + ch); l1v[q] = *(const f32x4*)(halo + ((size_t)pmp * 2 + 1) * DFF + ch);
                    w0v[q] = *(const f32x4*)(cw + ch); w1v[q] = *(const f32x4*)(cw + DFF + ch); w2v[q] = *(const f32x4*)(cw + 2 * DFF + ch); bbv[q] = *(const f32x4*)(cb + ch); }
#pragma unroll
                for (int q = 0; q < 2; ++q) if (ok[q]) { const bool first = (pmv[q] & 7) == 0; const f32x4 z = {0.f, 0.f, 0.f, 0.f};
                    const f32x4 L0 = first ? z : l0v[q], L1 = first ? z : l1v[q];
                    const f32x4 p1 = jv[q] ? f0v[q] : L1, p2 = jv[q] ? L1 : L0;
                    const f32x4 c = bbv[q] + w0v[q] * p2 + w1v[q] * p1 + w2v[q] * a0v[q];
                    u32x2 w; w.x = cvt_pk_bf16(fast_gelu(c[0]) * u0v[q][0], fast_gelu(c[1]) * u0v[q][1]); w.y = cvt_pk_bf16(fast_gelu(c[2]) * u0v[q][2], fast_gelu(c[3]) * u0v[q][3]);
                    *(u32x2*)(act + ((size_t)pmv[q] * 256 + jv[q]) * DFF + chv[q]) = w; }
            }
            asm volatile("s_waitcnt vmcnt(0)" ::: "memory"); __syncthreads();
        }
        pg8::EpResid<true> E{0, 0, (const void*)(ws + WS_X1B), (bf16_t*)(ws + WS_X2B), (float*)(ws + WS_PART2)};
        pg8::gemm_phase<pg8::EpResid<true>, pg8::StaticOrder, true, true>(lds + RING_OFF, g, S, E, wave);
        {
            pg8::Gemm gp{(const bf16_t*)(ws + WS_PB), (const bf16_t*)(ws + WS_WPP), M, DM, PLE}; pg8::StaticOrder Sp; Sp.init(M, DM, G, (int)blockIdx.x); Sp.ntk = PLE / 64;
            pg8::EpStore Ep{0, DM, (bf16_t*)(ws + WS_PP2)};
            pg8::gemm_phase<pg8::EpStore, pg8::StaticOrder, true, true>(lds + RING_OFF, gp, Sp, Ep, wave); }
        if (BOTH(7)) xcd_barrier(bar, wave);
    }
    if (IN(8)) {
        pg8::Gemm g{(const bf16_t*)(ws + WS_X2B), (const bf16_t*)(ws + WS_WPG), M, DM, DM}; pg8::StaticOrder S; S.init(M, DM, G, (int)blockIdx.x); S.ntk = DM / 64;
        pg8::Unit u0; (void)S.next(0, u0);
        {
            const int tid = wave * 64 + FRESH_LANE(); LAS float* tab = (LAS float*)(lds + EPI_OFF + 4096); pg8::Unit fu; int prev_pm = -1;
            for (int i = 0; S.next(i, fu); ++i) { if (fu.pm == prev_pm) continue; prev_pm = fu.pm; const int slot = (fu.pm - u0.pm) / pg8::WGM;
                if (tid < 256 && slot < 8) tab[slot * 256 + tid] = rstd_part((const float*)(ws + WS_PART2), fu.pm * 256 + tid); }
            __syncthreads();
        }
        pg8::EpFinalP E{u0.pm, pg8::WGM, (const float*)(ws + WS_PART2), (const bf16_t*)(ws + WS_PP2), (const bf16_t*)(ws + WS_X2B), out};
        pg8::gemm_phase<pg8::EpFinalP, pg8::StaticOrder, true, true>(lds + RING_OFF, g, S, E, wave);
    }
#undef IN
#undef BOTH
}

extern "C" void kernel_launch(void* const* d_in, const int* in_sizes, int n_in, void* d_out, int out_size, void* d_ws, size_t ws_size, hipStream_t stream) {
    static int grid = 0;
    if (grid == 0) {
        if (n_in != 18 || out_size != M * DM || ws_size < WS_END) { fprintf(stderr, "kernel_launch: unexpected sizes n_in %d out %d ws %zu\n", n_in, out_size, ws_size); grid = -1; return; }
        int dev = 0, cus = 0;
        if (hipGetDevice(&dev) != hipSuccess || hipDeviceGetAttribute(&cus, hipDeviceAttributeMultiprocessorCount, dev) != hipSuccess) { grid = -1; return; }
        if (hipFuncSetAttribute((const void*)mk_fwd, hipFuncAttributeMaxDynamicSharedMemorySize, LDS_BYTES) != hipSuccess) { fprintf(stderr, "kernel_launch: hipFuncSetAttribute failed\n"); grid = -1; return; }
        (void)hipGetLastError();
        grid = cus;
    }
    if (grid < 0) return;
    unsigned char* ws = (unsigned char*)d_ws; float* out = (float*)d_out;
    (void)hipMemsetAsync((char*)d_ws + WS_CTL, 0, CTL_ZERO_BYTES, stream);
    Args a{}; for (int i = 0; i < 18; ++i) a.in[i] = (const float*)d_in[i]; a.out = out; a.ws = ws;
    int li = 0;
#define MKF(lo_, hi_, fl_) do { a.ph_lo = (lo_); a.ph_hi = (hi_); a.pad = (fl_); a.li = li++; hipLaunchKernelGGL(mk_fwd, dim3(grid), dim3(NWAVES * 64), LDS_BYTES, stream, a); } while (0)
#define MK(lo_, hi_) MKF(lo_, hi_, 1)
#ifndef PROBE_PHASE
#define PROBE_PHASE -1
#endif
#ifndef PROBE_FLAGS
#define PROBE_FLAGS 1
#endif
    if (PROBE_PHASE < 0) MK(0, 9);
    else { MK(0, PROBE_PHASE + 1); MKF(PROBE_PHASE, PROBE_PHASE + 1, PROBE_FLAGS); if (PROBE_PHASE + 1 < 9) MK(PROBE_PHASE + 1, 9); }
}
```

```cpp
#include <hip/hip_runtime.h>
#include <stdint.h>
#include <stdio.h>

typedef unsigned short bf16_t;
typedef short bf16x8 __attribute__((ext_vector_type(8)));
typedef float f32x4 __attribute__((ext_vector_type(4)));
typedef float f32x2 __attribute__((ext_vector_type(2)));
typedef unsigned u32x4 __attribute__((ext_vector_type(4)));
typedef unsigned u32x2 __attribute__((ext_vector_type(2)));

constexpr int NB = 16, SEQ = 2048, DM = 1024, M = NB * SEQ;
constexpr int PLE = 256, DIN = 6656, DFF = 2816;
constexpr float EPS = 1e-6f;
constexpr float LOG2E = 1.4426950408889634f;
constexpr size_t MiB = 1u << 20;
constexpr size_t WS_CTL = 0, CTL_ZERO_BYTES = 256 * 1024;
constexpr size_t WS_RSTD0 = 1 * MiB, WS_RSTD1 = WS_RSTD0 + 128 * 1024, WS_RSTD2 = WS_RSTD1 + 128 * 1024;
constexpr size_t WS_ROPE = 2 * MiB;
constexpr size_t WS_W1 = 4 * MiB;
constexpr size_t WS_WAB = WS_W1 + (size_t)DIN * DM * 2;
constexpr size_t WS_WO = WS_WAB + (size_t)DM * 1536 * 2;
constexpr size_t WS_W2 = WS_WO + (size_t)DM * DM * 2;
constexpr size_t WS_W3 = WS_W2 + (size_t)2 * DFF * DM * 2;
constexpr size_t WS_WPG = WS_W3 + (size_t)DM * DFF * 2;
constexpr size_t WS_WPP = WS_WPG + (size_t)DM * DM * 2;
constexpr size_t WS_WEND = WS_WPP + (size_t)DM * PLE * 2;
static_assert(WS_WEND <= 44 * MiB, "weights");
constexpr size_t WS_PART1 = 44 * MiB, WS_PART2 = 46 * MiB;
constexpr size_t WS_QSB = 48 * MiB, WS_KSB = 80 * MiB, WS_VSB = 112 * MiB, WS_QR = 144 * MiB, WS_KR = 176 * MiB, WS_VR = 208 * MiB,
                 WS_SGR = 272 * MiB, WS_SA = 336 * MiB, WS_SB = 400 * MiB, WS_PB = 464 * MiB, WS_MISC = 480 * MiB, WS_END = 512 * MiB;
constexpr size_t WS_T1 = 48 * MiB;
constexpr size_t WS_MERGED = WS_SB;
constexpr size_t WS_X1B = 48 * MiB;
constexpr size_t WS_ARAW = 112 * MiB;
constexpr size_t WS_ACT = 288 * MiB;
constexpr size_t WS_PP2 = 112 * MiB;
constexpr size_t WS_X2B = 176 * MiB;
constexpr size_t WS_HALO = WS_MISC;
constexpr size_t HALO_ELEMS = (size_t)128 * 2 * DFF;
constexpr size_t WS_W2NAT = 492 * MiB;

__device__ __forceinline__ bf16_t f2bf(float f) { unsigned u = __builtin_bit_cast(unsigned, f); return (bf16_t)((u + 0x7fffu + ((u >> 16) & 1u)) >> 16); }
__device__ __forceinline__ float bf2f(bf16_t b) { return __builtin_bit_cast(float, (unsigned)b << 16); }
__device__ __forceinline__ float sigmoidf_(float x) { return 1.f / (1.f + __expf(-x)); }
__device__ __forceinline__ float gelu_tanh(float x) { const float u = 0.7978845608028654f * (x + 0.044715f * x * x * x); return x * sigmoidf_(2.f * u); }
__device__ __forceinline__ float fast_sigmoid(float x) { return __builtin_amdgcn_rcpf(1.f + __builtin_amdgcn_exp2f(-LOG2E * x)); }
__device__ __forceinline__ float sigmoid_z(float z) { return __builtin_amdgcn_rcpf(1.f + __builtin_amdgcn_exp2f(z)); }
__device__ __forceinline__ float fast_gelu(float x) { const float u = x * (-1.5957691216057308f * LOG2E - 0.0713548162726f * LOG2E * x * x); return x * __builtin_amdgcn_rcpf(1.f + __builtin_amdgcn_exp2f(u)); }
__device__ __forceinline__ unsigned cvt_pk_bf16(float lo, float hi) { unsigned r; asm volatile("v_cvt_pk_bf16_f32 %0, %1, %2" : "=v"(r) : "v"(lo), "v"(hi)); return r; }
__device__ __forceinline__ float rstd_part(const float* part, int row) {
    const f32x4* p = (const f32x4*)(part + (size_t)row * 16); const f32x4 a = p[0], b = p[1], c = p[2], d = p[3];
    const float s = ((a[0] + a[1]) + (a[2] + a[3])) + ((b[0] + b[1]) + (b[2] + b[3])) + ((c[0] + c[1]) + (c[2] + c[3])) + ((d[0] + d[1]) + (d[2] + d[3]));
    return 1.0f / sqrtf(s * (1.f / DM) + EPS);
}

namespace pg8 {
#define PG8_LAS __attribute__((address_space(3)))
typedef unsigned short bf16_t;
typedef short bf16x8 __attribute__((ext_vector_type(8)));
typedef float f32x4 __attribute__((ext_vector_type(4)));
typedef unsigned u32x4 __attribute__((ext_vector_type(4)));
constexpr int BM = 256, BK = 64, HALF = 128, HTB = HALF * BK * 2  , STAGE_BYTES = 8 * HTB, NXCD = 8, WGM = 4;

__host__ __device__ __forceinline__ int lds_byte(int r, int c) { const int st = (r >> 4) * 2 + (c >> 5), rr = r & 15, cc = c & 31, ob = rr * 64 + cc * 2; return st * 1024 + (ob ^ (((ob >> 9) & 1) << 5)); }
__host__ __device__ __forceinline__ void stage_rc(int b, int& R, int& C) { const int st = b / 1024, sb = b % 1024, swz = sb ^ (((sb >> 9) & 1) << 5); R = (st >> 1) * 16 + swz / 64; C = (st & 1) * 32 + (swz % 64) / 2; }
__host__ __device__ __forceinline__ int perm32(int rho) { const int n = rho >> 4, i = rho & 15; return 8 * (i >> 2) + 4 * n + (i & 3); }

struct Unit { int pm, pn, part; };
struct Gemm { const bf16_t* A; const bf16_t* Bt; int M, N, K; int lda; const bf16_t* A2; int lda2, pad2; };

struct StaticOrder {
    int nM, nN, nwg, G, c;
    __host__ __device__ void init(int M, int N, int G_, int c_) { nM = M / BM; nN = N / BM; nwg = nM * nN; G = G_; c = c_; }
    __host__ __device__ bool next(int i, Unit& u) const {
        const long L = (long)i * G + c; if (L >= nwg) return false;
        int wgid = (int)L; { const int q = nwg / NXCD, r = nwg % NXCD, xcd = wgid % NXCD, off = wgid / NXCD; wgid = (xcd < r ? xcd * (q + 1) : r * (q + 1) + (xcd - r) * q) + off; }
        const int nig = WGM * nN, gid = wgid / nig, fm = gid * WGM, gsz = (nM - fm) < WGM ? (nM - fm) : WGM;
        u.pm = fm + ((wgid % nig) % gsz); u.pn = (wgid % nig) / gsz; u.part = 0; return true;
    }
    int ntk;
    __device__ __forceinline__ int nt(const Unit&) const { return ntk; }
    __device__ __forceinline__ size_t koff(const Unit&) const { return 0; }
    __device__ __forceinline__ bool a_alt(const Unit&) const { return false; }
    __device__ __forceinline__ void a_ready(const Unit&) const {}
    __device__ __forceinline__ void done(const Unit&) const {}
};


struct PairOrder { StaticOrder base;
    __device__ __forceinline__ bool next(int i, Unit& u) const { if (!base.next(i >> 1, u)) return false; u.part = i & 1; return true; }
    __device__ __forceinline__ int nt(const Unit& u) const { return u.part ? 16 : 8; }
    __device__ __forceinline__ size_t koff(const Unit& u) const { return u.part ? 1024 : 0; }
    __device__ __forceinline__ bool a_alt(const Unit& u) const { return u.part == 0; }
    __device__ __forceinline__ void a_ready(const Unit&) const {}
    __device__ __forceinline__ void done(const Unit&) const {}
};
#define EPI_ARGS f32x4 (&acc)[2][2][4][2], const Unit& u, int wr, int wc, int fr, int fq, PG8_LAS unsigned char* lds, int wid, int lane
struct EpStore { int unused0; int ld; bf16_t* O;
    __device__ __forceinline__ bool keep(const Unit&) const { return false; }
    __device__ __forceinline__ void operator()(EPI_ARGS) const {
        { int l_; asm volatile("v_mbcnt_lo_u32_b32 %0, -1, 0\n\tv_mbcnt_hi_u32_b32 %0, -1, %0" : "=v"(l_)); fr = l_ & 15; fq = l_ >> 4; }
#pragma unroll
        for (int ai = 0; ai < 2; ++ai)
#pragma unroll
            for (int m = 0; m < 4; ++m) { const int row = u.pm * BM + ai * HALF + wr * 64 + m * 16 + fr;
#pragma unroll
                for (int bj = 0; bj < 2; ++bj) { const int col = u.pn * BM + bj * HALF + wc * 32 + 8 * fq; const f32x4 v0 = acc[ai][bj][m][0], v1 = acc[ai][bj][m][1];
                    u32x4 w; w.x = cvt_pk_bf16(v0[0], v0[1]); w.y = cvt_pk_bf16(v0[2], v0[3]); w.z = cvt_pk_bf16(v1[0], v1[1]); w.w = cvt_pk_bf16(v1[2], v1[3]);
                    *(u32x4*)(O + (size_t)row * ld + col) = w; } }
    }
};
template <bool BASE_BF16> struct EpResid { int unused0; int pad; const void* basev; bf16_t* ob; float* part;
    __device__ __forceinline__ bool keep(const Unit&) const { return false; }
    __device__ __forceinline__ void operator()(EPI_ARGS) const {
        { int l_; asm volatile("v_mbcnt_lo_u32_b32 %0, -1, 0\n\tv_mbcnt_hi_u32_b32 %0, -1, %0" : "=v"(l_)); fr = l_ & 15; fq = l_ >> 4; }
#pragma unroll
        for (int ai = 0; ai < 2; ++ai) {
            f32x4 pf32[BASE_BF16 ? 1 : 4][2][2]; u32x4 pb16[BASE_BF16 ? 4 : 1][2];
#pragma unroll
            for (int m = 0; m < 4; ++m)
#pragma unroll
                for (int bj = 0; bj < 2; ++bj) { const size_t o = (size_t)(u.pm * BM + ai * HALF + wr * 64 + m * 16 + fr) * DM + u.pn * BM + bj * HALF + wc * 32 + 8 * fq;
                    if constexpr (BASE_BF16) pb16[m][bj] = *(const u32x4*)((const bf16_t*)basev + o);
                    else { pf32[m][bj][0] = *(const f32x4*)((const float*)basev + o); pf32[m][bj][1] = *(const f32x4*)((const float*)basev + o + 4); } }
#pragma unroll
            for (int m = 0; m < 4; ++m) { const int row = u.pm * BM + ai * HALF + wr * 64 + m * 16 + fr; float ss = 0.f;
#pragma unroll
                for (int bj = 0; bj < 2; ++bj) { const size_t o = (size_t)row * DM + u.pn * BM + bj * HALF + wc * 32 + 8 * fq;
                    f32x4 r0, r1;
                    if constexpr (BASE_BF16) { const u32x4 bw = pb16[m][bj];
                        r0 = (f32x4){__builtin_bit_cast(float, bw.x << 16), __builtin_bit_cast(float, bw.x & 0xffff0000u), __builtin_bit_cast(float, bw.y << 16), __builtin_bit_cast(float, bw.y & 0xffff0000u)};
                        r1 = (f32x4){__builtin_bit_cast(float, bw.z << 16), __builtin_bit_cast(float, bw.z & 0xffff0000u), __builtin_bit_cast(float, bw.w << 16), __builtin_bit_cast(float, bw.w & 0xffff0000u)}; }
                    else { r0 = pf32[m][bj][0]; r1 = pf32[m][bj][1]; }
                    r0 = r0 + acc[ai][bj][m][0]; r1 = r1 + acc[ai][bj][m][1];
                    ss += (r0[0] * r0[0] + r0[1] * r0[1]) + (r0[2] * r0[2] + r0[3] * r0[3]) + (r1[0] * r1[0] + r1[1] * r1[1]) + (r1[2] * r1[2] + r1[3] * r1[3]);
                    u32x4 w; w.x = cvt_pk_bf16(r0[0], r0[1]); w.y = cvt_pk_bf16(r0[2], r0[3]); w.z = cvt_pk_bf16(r1[0], r1[1]); w.w = cvt_pk_bf16(r1[2], r1[3]);
                    *(u32x4*)(ob + o) = w; }
                ss += __shfl_xor(ss, 16); ss += __shfl_xor(ss, 32);
                if (fq == 0) part[(size_t)row * 16 + u.pn * 4 + wc] = ss; }
            asm volatile("" ::: "memory"); }
    }
};
struct EpFinalP { int pm0; int wgm; const float* part; const bf16_t* pp; const bf16_t* x2b; float* out;
    __device__ __forceinline__ bool keep(const Unit&) const { return false; }
    __device__ __forceinline__ void operator()(EPI_ARGS) const {
        { int l_; asm volatile("v_mbcnt_lo_u32_b32 %0, -1, 0\n\tv_mbcnt_hi_u32_b32 %0, -1, %0" : "=v"(l_)); fr = l_ & 15; fq = l_ >> 4; }
#pragma unroll
        for (int ai = 0; ai < 2; ++ai) {
            u32x4 pwv[4][2], xwv[4][2];
#pragma unroll
            for (int m = 0; m < 4; ++m)
#pragma unroll
                for (int bj = 0; bj < 2; ++bj) { const size_t o = (size_t)(u.pm * BM + ai * HALF + wr * 64 + m * 16 + fr) * DM + u.pn * BM + bj * HALF + wc * 32 + 8 * fq; pwv[m][bj] = *(const u32x4*)(pp + o); xwv[m][bj] = *(const u32x4*)(x2b + o); }
#pragma unroll
            for (int m = 0; m < 4; ++m) { const int row = u.pm * BM + ai * HALF + wr * 64 + m * 16 + fr;
                const float rs = ((const PG8_LAS float*)(lds + 131072 + 1024 + 4096))[((u.pm - pm0) / wgm) * 256 + ai * HALF + wr * 64 + m * 16 + fr];
#pragma unroll
                for (int bj = 0; bj < 2; ++bj) { const size_t o = (size_t)row * DM + u.pn * BM + bj * HALF + wc * 32 + 8 * fq;
                    const u32x4 pw = pwv[m][bj], xw = xwv[m][bj];
                    const float rsl = -LOG2E * rs; const f32x4 a0 = acc[ai][bj][m][0] * rsl, a1 = acc[ai][bj][m][1] * rsl; f32x4 r0, r1;
#define LO_(w) __builtin_bit_cast(float, (w) << 16)
#define HI_(w) __builtin_bit_cast(float, (w) & 0xffff0000u)
                    r0[0] = LO_(xw.x) + sigmoid_z(a0[0]) * LO_(pw.x); r0[1] = HI_(xw.x) + sigmoid_z(a0[1]) * HI_(pw.x); r0[2] = LO_(xw.y) + sigmoid_z(a0[2]) * LO_(pw.y); r0[3] = HI_(xw.y) + sigmoid_z(a0[3]) * HI_(pw.y);
                    r1[0] = LO_(xw.z) + sigmoid_z(a1[0]) * LO_(pw.z); r1[1] = HI_(xw.z) + sigmoid_z(a1[1]) * HI_(pw.z); r1[2] = LO_(xw.w) + sigmoid_z(a1[2]) * LO_(pw.w); r1[3] = HI_(xw.w) + sigmoid_z(a1[3]) * HI_(pw.w);
#undef LO_
#undef HI_
                    *(f32x4*)(out + o) = r0; *(f32x4*)(out + o + 4) = r1; } }
            asm volatile("" ::: "memory"); }
    }
};
struct EpMerged { int unused0; int pad; const bf16_t* sA; bf16_t* sB;
    __device__ __forceinline__ bool keep(const Unit& u) const { return u.part == 0; }
    __device__ __forceinline__ void ratio(f32x4 (&acc)[2][2][4][2], const Unit& u, int wr, int wc, int fr, int fq) const {
#pragma unroll
        for (int ai = 0; ai < 2; ++ai) {
            u32x4 rv[4][2];
#pragma unroll
            for (int m = 0; m < 4; ++m)
#pragma unroll
                for (int bj = 0; bj < 2; ++bj) rv[m][bj] = *(const u32x4*)(sA + (size_t)(u.pm * BM + ai * HALF + wr * 64 + m * 16 + fr) * DM + u.pn * BM + bj * HALF + wc * 32 + 8 * fq);
#pragma unroll
            for (int m = 0; m < 4; ++m)
#pragma unroll
                for (int bj = 0; bj < 2; ++bj) { const u32x4 a = rv[m][bj];
                    acc[ai][bj][m][0][0] *= __builtin_bit_cast(float, a.x << 16); acc[ai][bj][m][0][1] *= __builtin_bit_cast(float, a.x & 0xffff0000u); acc[ai][bj][m][0][2] *= __builtin_bit_cast(float, a.y << 16); acc[ai][bj][m][0][3] *= __builtin_bit_cast(float, a.y & 0xffff0000u);
                    acc[ai][bj][m][1][0] *= __builtin_bit_cast(float, a.z << 16); acc[ai][bj][m][1][1] *= __builtin_bit_cast(float, a.z & 0xffff0000u); acc[ai][bj][m][1][2] *= __builtin_bit_cast(float, a.w << 16); acc[ai][bj][m][1][3] *= __builtin_bit_cast(float, a.w & 0xffff0000u); }
            asm volatile("" ::: "memory"); }
    }
    __device__ __forceinline__ void operator()(EPI_ARGS) const {
        { int l_; asm volatile("v_mbcnt_lo_u32_b32 %0, -1, 0\n\tv_mbcnt_hi_u32_b32 %0, -1, %0" : "=v"(l_)); fr = l_ & 15; fq = l_ >> 4; }
        if (u.part == 0) { ratio(acc, u, wr, wc, fr, fq); return; }
#pragma unroll
        for (int ai = 0; ai < 2; ++ai) {
            u32x4 bv[4][2];
#pragma unroll
            for (int m = 0; m < 4; ++m)
#pragma unroll
                for (int bj = 0; bj < 2; ++bj) bv[m][bj] = *(const u32x4*)(sB + (size_t)(u.pm * BM + ai * HALF + wr * 64 + m * 16 + fr) * DM + u.pn * BM + bj * HALF + wc * 32 + 8 * fq);
#pragma unroll
            for (int m = 0; m < 4; ++m) { const int row = u.pm * BM + ai * HALF + wr * 64 + m * 16 + fr;
#pragma unroll
                for (int bj = 0; bj < 2; ++bj) { const size_t o = (size_t)row * DM + u.pn * BM + bj * HALF + wc * 32 + 8 * fq;
                    const u32x4 b = bv[m][bj]; const f32x4 v0 = acc[ai][bj][m][0], v1 = acc[ai][bj][m][1];
#define LO(w) fmaxf(__builtin_bit_cast(float, (w) << 16), 1e-30f)
#define HI(w) fmaxf(__builtin_bit_cast(float, (w) & 0xffff0000u), 1e-30f)
                    u32x4 w; w.x = cvt_pk_bf16(v0[0] * LO(b.x), v0[1] * HI(b.x)); w.y = cvt_pk_bf16(v0[2] * LO(b.y), v0[3] * HI(b.y));
                    w.z = cvt_pk_bf16(v1[0] * LO(b.z), v1[1] * HI(b.z)); w.w = cvt_pk_bf16(v1[2] * LO(b.w), v1[3] * HI(b.w));
#undef LO
#undef HI
                    *(u32x4*)(sB + o) = w; } }
            asm volatile("" ::: "memory"); }
    }
};
struct EpProj { int pn_base; int pad; const float* rstd0; unsigned char* ws; const float* gq; const float* gk; const float* rope;
    __device__ __forceinline__ bool keep(const Unit&) const { return false; }
    __device__ __forceinline__ void operator()(EPI_ARGS) const {
        { int l_; asm volatile("v_mbcnt_lo_u32_b32 %0, -1, 0\n\tv_mbcnt_hi_u32_b32 %0, -1, %0" : "=v"(l_)); fr = l_ & 15; fq = l_ >> 4; }
        const int pn = u.pn + pn_base;
        if (pn < 4) {
            const bool isq = pn < 2; bf16_t* dst = (bf16_t*)(ws + (isq ? WS_QSB : WS_KSB)); const float* gain = isq ? gq : gk; const float scale = isq ? 0.125f * LOG2E : 1.f;
            const int h = 4 * (pn & 1) + wc;
            f32x4 gv[2][2];
#pragma unroll
            for (int bj = 0; bj < 2; ++bj)
#pragma unroll
                for (int n = 0; n < 2; ++n) gv[bj][n] = *(const f32x4*)(gain + h * 64 + 32 * bj + 8 * fq + 4 * n);
#pragma unroll
            for (int ai = 0; ai < 2; ++ai)
#pragma unroll
                for (int m = 0; m < 4; ++m) { const int row = u.pm * BM + ai * HALF + wr * 64 + m * 16 + fr; const float rs = rstd0[row];
                    f32x4 v[2][2]; float ss = 0.f;
#pragma unroll
                    for (int bj = 0; bj < 2; ++bj)
#pragma unroll
                        for (int n = 0; n < 2; ++n) { v[bj][n] = acc[ai][bj][m][n] * rs; ss += (v[bj][n][0] * v[bj][n][0] + v[bj][n][1] * v[bj][n][1]) + (v[bj][n][2] * v[bj][n][2] + v[bj][n][3] * v[bj][n][3]); }
                    ss += __shfl_xor(ss, 16); ss += __shfl_xor(ss, 32);
                    const float r = scale / sqrtf(ss * (1.f / 64.f) + EPS);
#pragma unroll
                    for (int bj = 0; bj < 2; ++bj) { const f32x4 o0 = v[bj][0] * gv[bj][0] * r, o1 = v[bj][1] * gv[bj][1] * r;
                        u32x4 w; w.x = cvt_pk_bf16(o0[0], o0[1]); w.y = cvt_pk_bf16(o0[2], o0[3]); w.z = cvt_pk_bf16(o1[0], o1[1]); w.w = cvt_pk_bf16(o1[2], o1[3]);
                        *(u32x4*)(dst + (size_t)row * 512 + h * 64 + 32 * bj + 8 * fq) = w; } }
        } else if (pn >= 6 && pn < 10) {
            const bool isq = pn < 8; bf16_t* dst = (bf16_t*)(ws + (isq ? WS_QR : WS_KR)); const int h = 4 * (pn & 1) + wc;
            const float lg = log2f(1.f - exp2f(-5.f - (float)h));
#pragma unroll
            for (int ai = 0; ai < 2; ++ai)
#pragma unroll
                for (int m = 0; m < 4; ++m) { const int row = u.pm * BM + ai * HALF + wr * 64 + m * 16 + fr; const int t = row & (SEQ - 1); const float ic = (float)(t & 127);
                    const float sc = rstd0[row] * (isq ? exp2f(lg * ic) : 0.125f * exp2f(-lg * ic));
                    u32x4 w1, w2;
#pragma unroll
                    for (int n = 0; n < 2; ++n) { const f32x4 c = *(const f32x4*)(rope + (size_t)t * 32 + 8 * fq + 4 * n), s = *(const f32x4*)(rope + (size_t)SEQ * 32 + (size_t)t * 32 + 8 * fq + 4 * n);
                        const f32x4 x1 = acc[ai][0][m][n], x2 = acc[ai][1][m][n]; const f32x4 o1 = (x1 * c - x2 * s) * sc, o2 = (x1 * s + x2 * c) * sc;
                        if (n == 0) { w1.x = cvt_pk_bf16(o1[0], o1[1]); w1.y = cvt_pk_bf16(o1[2], o1[3]); w2.x = cvt_pk_bf16(o2[0], o2[1]); w2.y = cvt_pk_bf16(o2[2], o2[3]); }
                        else { w1.z = cvt_pk_bf16(o1[0], o1[1]); w1.w = cvt_pk_bf16(o1[2], o1[3]); w2.z = cvt_pk_bf16(o2[0], o2[1]); w2.w = cvt_pk_bf16(o2[2], o2[3]); } }
                    bf16_t* dp = dst + ((size_t)((row >> 11) * 8 + h) * SEQ + t) * 64 + 8 * fq;
                    *(u32x4*)dp = w1; *(u32x4*)(dp + 32) = w2; }
        } else if (pn >= 18) {
            bf16_t* dR = (bf16_t*)(ws + WS_SA); bf16_t* dB = (bf16_t*)(ws + WS_SB); const int c0 = (pn - 18) * 128 + wc * 32 + 8 * fq;
#pragma unroll
            for (int ai = 0; ai < 2; ++ai)
#pragma unroll
                for (int m = 0; m < 4; ++m) { const int row = u.pm * BM + ai * HALF + wr * 64 + m * 16 + fr; const float rsl = -LOG2E * rstd0[row];
                    f32x4 rr[2], sb[2];
#pragma unroll
                    for (int n = 0; n < 2; ++n)
#pragma unroll
                        for (int i = 0; i < 4; ++i) {
                            const float da = 1.f + __builtin_amdgcn_exp2f(acc[ai][0][m][n][i] * rsl), db = 1.f + __builtin_amdgcn_exp2f(fminf(acc[ai][1][m][n][i] * rsl, 100.f));
                            sb[n][i] = __builtin_amdgcn_rcpf(db); rr[n][i] = db * __builtin_amdgcn_rcpf(da); }
                    u32x4 w; w.x = cvt_pk_bf16(rr[0][0], rr[0][1]); w.y = cvt_pk_bf16(rr[0][2], rr[0][3]); w.z = cvt_pk_bf16(rr[1][0], rr[1][1]); w.w = cvt_pk_bf16(rr[1][2], rr[1][3]);
                    *(u32x4*)(dR + (size_t)row * DM + c0) = w;
                    u32x4 x; x.x = cvt_pk_bf16(sb[0][0], sb[0][1]); x.y = cvt_pk_bf16(sb[0][2], sb[0][3]); x.z = cvt_pk_bf16(sb[1][0], sb[1][1]); x.w = cvt_pk_bf16(sb[1][2], sb[1][3]);
                    *(u32x4*)(dB + (size_t)row * DM + c0) = x; }
        } else {
            bf16_t* dst; int ld, cbase, actk;
            if (pn < 6) { dst = (bf16_t*)(ws + WS_VSB); ld = 512; cbase = (pn - 4) * 256; actk = 0; }
            else if (pn < 14) { dst = (bf16_t*)(ws + WS_VR); ld = 1024; cbase = (pn - 10) * 256; actk = 0; }
            else if (pn < 18) { dst = (bf16_t*)(ws + WS_SGR); ld = 1024; cbase = (pn - 14) * 256; actk = 1; }
            else if (pn < 22) { dst = (bf16_t*)(ws + WS_SA); ld = 1024; cbase = (pn - 18) * 256; actk = 2; }
            else { dst = (bf16_t*)(ws + WS_SB); ld = 1024; cbase = (pn - 22) * 256; actk = 2; }
#pragma unroll
            for (int ai = 0; ai < 2; ++ai)
#pragma unroll
                for (int m = 0; m < 4; ++m) { const int row = u.pm * BM + ai * HALF + wr * 64 + m * 16 + fr; const float rs = rstd0[row];
#pragma unroll
                    for (int bj = 0; bj < 2; ++bj) { f32x4 v0 = acc[ai][bj][m][0] * rs, v1 = acc[ai][bj][m][1] * rs;
                        if (actk) { const float rsl = -LOG2E * rs; const f32x4 z0 = acc[ai][bj][m][0] * rsl, z1 = acc[ai][bj][m][1] * rsl;
#pragma unroll
                            for (int i = 0; i < 4; ++i) { const float s0 = sigmoid_z(z0[i]), s1 = sigmoid_z(z1[i]); v0[i] = actk == 1 ? v0[i] * s0 : s0; v1[i] = actk == 1 ? v1[i] * s1 : s1; } }
                        u32x4 w; w.x = cvt_pk_bf16(v0[0], v0[1]); w.y = cvt_pk_bf16(v0[2], v0[3]); w.z = cvt_pk_bf16(v1[0], v1[1]); w.w = cvt_pk_bf16(v1[2], v1[3]);
                        if (pn >= 10 && pn < 18) *(u32x4*)(dst + ((size_t)((row >> 11) * 8 + (cbase >> 7) + bj) * SEQ + (row & (SEQ - 1))) * 128 + wc * 32 + 8 * fq) = w;
                        else *(u32x4*)(dst + (size_t)row * ld + cbase + bj * HALF + wc * 32 + 8 * fq) = w; } }
        }
    }
};
__device__ __forceinline__ float dpp_ror1(float v) { return __builtin_bit_cast(float, __builtin_amdgcn_update_dpp(0, __builtin_bit_cast(int, v), 0x121, 0xF, 0xF, false)); }
__device__ __forceinline__ float dpp_ror2(float v) { return __builtin_bit_cast(float, __builtin_amdgcn_update_dpp(0, __builtin_bit_cast(int, v), 0x122, 0xF, 0xF, false)); }
struct EpUp { int pm0; int wgm; const float* part1; const float* cw; const float* cb; bf16_t* act; float* halo;
    __device__ __forceinline__ bool keep(const Unit&) const { return false; }
    __device__ __forceinline__ void operator()(EPI_ARGS) const {
        { int l_; asm volatile("v_mbcnt_lo_u32_b32 %0, -1, 0\n\tv_mbcnt_hi_u32_b32 %0, -1, %0" : "=v"(l_)); fr = l_ & 15; fq = l_ >> 4; }
        const int ch0 = u.pn * 128 + wc * 32 + 8 * fq;
        PG8_LAS float* X = (PG8_LAS float*)(lds + 131072 + 1024);
        f32x4 cw0[2], cw1[2], cw2[2], cbb[2];
#pragma unroll
        for (int n = 0; n < 2; ++n) { cw0[n] = *(const f32x4*)(cw + ch0 + 4 * n); cw1[n] = *(const f32x4*)(cw + DFF + ch0 + 4 * n); cw2[n] = *(const f32x4*)(cw + 2 * DFF + ch0 + 4 * n); cbb[n] = *(const f32x4*)(cb + ch0 + 4 * n); }
        float rsv[2][4];
#pragma unroll
        for (int ai = 0; ai < 2; ++ai)
#pragma unroll
            for (int m = 0; m < 4; ++m) rsv[ai][m] = ((const PG8_LAS float*)(lds + 131072 + 1024 + 4096))[((u.pm - pm0) / wgm) * 256 + ai * HALF + wr * 64 + m * 16 + fr];
        if (fr >= 14) {
#pragma unroll
            for (int ai = 0; ai < 2; ++ai)
#pragma unroll
                for (int n = 0; n < 2; ++n) *(PG8_LAS f32x4*)(X + (((ai * 2 + wr) * 4 + wc) * 2 + (fr - 14)) * 32 + 8 * fq + 4 * n) = acc[ai][0][3][n] * rsv[ai][3];
            if (wr == 1) {
#pragma unroll
                for (int n = 0; n < 2; ++n) *(f32x4*)(halo + ((size_t)u.pm * 2 + (fr - 14)) * DFF + ch0 + 4 * n) = acc[1][0][3][n] * rsv[1][3]; }
        }
        if (fr < 2 && wr == 0) {
#pragma unroll
            for (int n = 0; n < 2; ++n) { *(f32x4*)(halo + HALO_ELEMS + ((size_t)u.pm * 2 + fr) * DFF + ch0 + 4 * n) = acc[0][0][0][n] * rsv[0][0];
                                          *(f32x4*)(halo + 2 * HALO_ELEMS + ((size_t)u.pm * 2 + fr) * DFF + ch0 + 4 * n) = acc[0][1][0][n] * rsv[0][0]; }
        }
        asm volatile("s_waitcnt lgkmcnt(0)" ::: "memory"); __builtin_amdgcn_s_barrier(); asm volatile("" ::: "memory");
        const bool l15 = fr == 15, l14 = fr >= 14;
#pragma unroll
        for (int n = 0; n < 2; ++n) {
            const f32x4 w0 = cw0[n], w1 = cw1[n], w2 = cw2[n], bb = cbb[n];
#pragma unroll
            for (int ai = 0; ai < 2; ++ai) {
                f32x4 pv;
#pragma unroll
                for (int m = 0; m < 4; ++m) { const int row = u.pm * BM + ai * HALF + wr * 64 + m * 16 + fr;
                    const f32x4 cur = acc[ai][0][m][n] * rsv[ai][m];
                    f32x4 e1, e2;
                    if (m == 0) {
                        const int sai = wr == 1 ? ai : ai - 1, swr = wr == 1 ? 0 : 1;
                        if (sai >= 0) { const f32x4 q14 = *(const PG8_LAS f32x4*)(X + (((sai * 2 + swr) * 4 + wc) * 2 + 0) * 32 + 8 * fq + 4 * n); e1 = *(const PG8_LAS f32x4*)(X + (((sai * 2 + swr) * 4 + wc) * 2 + 1) * 32 + 8 * fq + 4 * n);
#pragma unroll
                            for (int i = 0; i < 4; ++i) e2[i] = l15 ? e1[i] : q14[i]; }
                        else { e1 = e2 = (f32x4){0.f, 0.f, 0.f, 0.f}; }
                    } else { e1 = pv; e2 = pv; }
                    f32x4 t1, t2; f32x4 c = bb + w2 * cur;
#pragma unroll
                    for (int i = 0; i < 4; ++i) { t1[i] = l15 ? e1[i] : cur[i]; t2[i] = l14 ? e2[i] : cur[i]; }
                    asm("s_nop 1\n\t"
                        "v_fmac_f32_dpp %0, %4, %12 row_ror:1 row_mask:0xf bank_mask:0xf\n\tv_fmac_f32_dpp %1, %5, %13 row_ror:1 row_mask:0xf bank_mask:0xf\n\t"
                        "v_fmac_f32_dpp %2, %6, %14 row_ror:1 row_mask:0xf bank_mask:0xf\n\tv_fmac_f32_dpp %3, %7, %15 row_ror:1 row_mask:0xf bank_mask:0xf\n\t"
                        "v_fmac_f32_dpp %0, %8, %16 row_ror:2 row_mask:0xf bank_mask:0xf\n\tv_fmac_f32_dpp %1, %9, %17 row_ror:2 row_mask:0xf bank_mask:0xf\n\t"
                        "v_fmac_f32_dpp %2, %10, %18 row_ror:2 row_mask:0xf bank_mask:0xf\n\tv_fmac_f32_dpp %3, %11, %19 row_ror:2 row_mask:0xf bank_mask:0xf"
                        : "+v"(c[0]), "+v"(c[1]), "+v"(c[2]), "+v"(c[3])
                        : "v"(t1[0]), "v"(t1[1]), "v"(t1[2]), "v"(t1[3]), "v"(t2[0]), "v"(t2[1]), "v"(t2[2]), "v"(t2[3]),
                          "v"(w1[0]), "v"(w1[1]), "v"(w1[2]), "v"(w1[3]), "v"(w0[0]), "v"(w0[1]), "v"(w0[2]), "v"(w0[3]));
                    const f32x4 uu = acc[ai][1][m][n] * rsv[ai][m];
                    u32x2 w; w.x = cvt_pk_bf16(fast_gelu(c[0]) * uu[0], fast_gelu(c[1]) * uu[1]); w.y = cvt_pk_bf16(fast_gelu(c[2]) * uu[2], fast_gelu(c[3]) * uu[3]);
                    if (!(ai == 0 && m == 0 && wr == 0 && fr < 2)) *(u32x2*)(act + (size_t)row * DFF + ch0 + 4 * n) = w;
                    pv = cur;
                    if (m & 1) asm volatile("" ::: "memory"); }
            }
        }
        asm volatile("s_waitcnt lgkmcnt(0)" ::: "memory"); __builtin_amdgcn_s_barrier(); asm volatile("" ::: "memory");
    }
};

template <class Epi, class Sched, bool ALIGN_EPI = false, bool SP2 = false, bool VARA = false>
__device__ __forceinline__ void gemm_phase(PG8_LAS unsigned char* lds, const Gemm g, const Sched& S, const Epi& E, const int wid) {
    int lane; asm volatile("v_mbcnt_lo_u32_b32 %0, -1, 0\n\tv_mbcnt_hi_u32_b32 %0, -1, %0" : "=v"(lane));
    const int tid = wid * 64 + lane, wr = wid >> 2, wc = wid & 3, fr = lane & 15, fq = lane >> 4;
    const int K = g.K;
    const int lda = g.lda ? g.lda : K, lda2 = VARA ? g.lda2 : 0;
    unsigned voffA[2], voffB[2], voffA2[2];
#pragma unroll
    for (int i = 0; i < 2; ++i) { int R, C; stage_rc(tid * 16 + i * 8192, R, C); const int Rb = (R & ~31) + perm32(R & 31);
        voffA[i] = (unsigned)(R * lda + C) * 2u; voffB[i] = (unsigned)(Rb * K + C) * 2u; voffA2[i] = (unsigned)(R * lda2 + C) * 2u; }
    const size_t kstep = (size_t)(BK * 2);
    const size_t hstep = (size_t)HALF * K * 2;
    const size_t tstep = 2 * hstep;
    const size_t hstepA = (size_t)HALF * lda * 2, hstepA2 = (size_t)HALF * lda2 * 2;
#define PG8_ABASE(u_) ((VARA && S.a_alt(u_)) ? (const char*)g.A2 + (size_t)(u_).pm * 2 * hstepA2 : (const char*)g.A + (size_t)(u_).pm * 2 * hstepA + (VARA ? (size_t)0 : S.koff(u_)))
    const unsigned ldsw = (unsigned)wid * 1024u;
    const int aoff = lds_byte(wr * 64 + fr, fq * 8), boff = lds_byte(wc * 32 + fr, fq * 8);
#define PG8_SA(b, h) (((b) * 2 + (h)) * HTB)
#define PG8_SB(b, h) ((4 + (b) * 2 + (h)) * HTB)
#define PG8_STAGE(bufoff, gbase, voff) do { _Pragma("unroll") for (int _i = 0; _i < 2; ++_i) \
        __builtin_amdgcn_global_load_lds((const unsigned*)((const char*)(gbase) + (voff)[_i]), (PG8_LAS unsigned*)(lds + (bufoff) + ldsw + _i * 8192), 16, 0, 0); } while (0)
#define PG8_LDA(dst, b, h) do { _Pragma("unroll") for (int m = 0; m < 4; ++m) _Pragma("unroll") for (int k = 0; k < 2; ++k) dst[m][k] = *(const PG8_LAS bf16x8*)(lds + PG8_SA(b, h) + aoff + m * 2048 + k * 1024); } while (0)
#define PG8_LDB(dst, b, h) do { _Pragma("unroll") for (int n = 0; n < 2; ++n) _Pragma("unroll") for (int k = 0; k < 2; ++k) dst[n][k] = *(const PG8_LAS bf16x8*)(lds + PG8_SB(b, h) + boff + n * 2048 + k * 1024); } while (0)
#define PG8_MMA(ai, bj, At, Bt) do { __builtin_amdgcn_s_setprio(1); _Pragma("unroll") for (int m = 0; m < 4; ++m) _Pragma("unroll") for (int n = 0; n < 2; ++n) _Pragma("unroll") for (int k = 0; k < 2; ++k) \
        acc[ai][bj][m][n] = __builtin_amdgcn_mfma_f32_16x16x32_bf16(Bt[n][k], At[m][k], acc[ai][bj][m][n], 0, 0, 0); __builtin_amdgcn_s_setprio(0); } while (0)
#define PG8_WAIT_V(n) asm volatile("s_waitcnt vmcnt(" #n ")" ::: "memory")
#define PG8_WAIT_L(n) asm volatile("s_waitcnt lgkmcnt(" #n ")" ::: "memory")
#define PG8_BAR __builtin_amdgcn_s_barrier()
#define PG8_SCHED __builtin_amdgcn_sched_barrier(0)
    Unit cur, nxt; int ui = 0;
    if (!S.next(0, cur)) return;
    f32x4 acc[2][2][4][2];
#pragma unroll
    for (int a = 0; a < 2; ++a)
#pragma unroll
        for (int b = 0; b < 2; ++b)
#pragma unroll
            for (int m = 0; m < 4; ++m)
#pragma unroll
                for (int n = 0; n < 2; ++n) acc[a][b][m][n] = (f32x4){0.f, 0.f, 0.f, 0.f};
    bf16x8 At[4][2], B0[2][2], B1[2][2];
    const char* cA = PG8_ABASE(cur); const char* cB = (const char*)g.Bt + (size_t)cur.pn * tstep + S.koff(cur);
    S.a_ready(cur);
    if constexpr (SP2) {
        const bool alt0 = VARA && S.a_alt(cur); const unsigned vA0[2] = {alt0 ? voffA2[0] : voffA[0], alt0 ? voffA2[1] : voffA[1]}; const size_t hA0 = alt0 ? hstepA2 : hstepA;
        PG8_STAGE(PG8_SB(0, 0), cB, voffB); PG8_STAGE(PG8_SB(0, 1), cB + hstep, voffB); PG8_STAGE(PG8_SA(0, 0), cA, vA0); PG8_STAGE(PG8_SA(0, 1), cA + hA0, vA0);
        if (wr == 1) PG8_BAR;
        PG8_WAIT_V(2); PG8_BAR;
        PG8_STAGE(PG8_SB(1, 0), cB + kstep, voffB); PG8_STAGE(PG8_SA(1, 0), cA + kstep, vA0); PG8_STAGE(PG8_SB(1, 1), cB + hstep + kstep, voffB);
        PG8_WAIT_V(6); PG8_BAR;
    } else {
        PG8_STAGE(PG8_SB(0, 0), cB, voffB); PG8_STAGE(PG8_SA(0, 0), cA, voffA); PG8_STAGE(PG8_SB(0, 1), cB + hstep, voffB); PG8_STAGE(PG8_SA(0, 1), cA + hstep, voffA);
        if (wr == 1) PG8_BAR;
        PG8_WAIT_V(4); PG8_BAR;
        PG8_STAGE(PG8_SB(1, 0), cB + kstep, voffB); PG8_STAGE(PG8_SA(1, 0), cA + kstep, voffA); PG8_STAGE(PG8_SB(1, 1), cB + hstep + kstep, voffB);
        PG8_WAIT_V(6); PG8_BAR;
    }
    for (;;) {
        const bool has_next = S.next(ui + 1, nxt);
        const int nt = S.nt(cur);
        const char* nA = has_next ? PG8_ABASE(nxt) : cA; const char* nB = has_next ? (const char*)g.Bt + (size_t)nxt.pn * tstep + S.koff(nxt) : cB;
        for (int t = 0; t < nt; t += 2) {
            const bool last = (t == nt - 2);
            const char* a1 = cA + (size_t)(t + 1) * kstep;
            const char* a2 = last ? nA : cA + (size_t)(t + 2) * kstep; const char* b2 = last ? nB : cB + (size_t)(t + 2) * kstep;
            const char* a3 = a2 + kstep; const char* b3 = b2 + kstep;
            if (last && has_next) S.a_ready(nxt);
            const bool altc = VARA && S.a_alt(cur), alt2 = VARA && ((last && has_next) ? S.a_alt(nxt) : S.a_alt(cur));
            const unsigned vAc[2] = {altc ? voffA2[0] : voffA[0], altc ? voffA2[1] : voffA[1]}, vA2[2] = {alt2 ? voffA2[0] : voffA[0], alt2 ? voffA2[1] : voffA[1]};
            const size_t hAc = altc ? hstepA2 : hstepA, hA2 = alt2 ? hstepA2 : hstepA;
            if constexpr (SP2) {
            PG8_LDB(B0, 0, 0); PG8_LDB(B1, 0, 1); PG8_SCHED; PG8_LDA(At, 0, 0); PG8_STAGE(PG8_SA(1, 1), a1 + hAc, vAc);
            PG8_WAIT_V(8); PG8_WAIT_L(0); PG8_BAR; PG8_MMA(0, 0, At, B0); PG8_MMA(0, 1, At, B1); PG8_BAR; PG8_SCHED;
            PG8_LDA(At, 0, 1); PG8_STAGE(PG8_SB(0, 0), b2, voffB); PG8_STAGE(PG8_SB(0, 1), b2 + hstep, voffB); PG8_STAGE(PG8_SA(0, 0), a2, vA2);
            PG8_WAIT_V(8); PG8_WAIT_L(0); PG8_BAR; PG8_MMA(1, 0, At, B0); PG8_MMA(1, 1, At, B1); PG8_BAR; PG8_SCHED;
            PG8_LDB(B0, 1, 0); PG8_LDB(B1, 1, 1); PG8_SCHED; PG8_LDA(At, 1, 0); PG8_STAGE(PG8_SA(0, 1), a2 + hA2, vA2);
            PG8_WAIT_V(8); PG8_WAIT_L(0); PG8_BAR; PG8_MMA(0, 0, At, B0); PG8_MMA(0, 1, At, B1); PG8_BAR; PG8_SCHED;
            PG8_LDA(At, 1, 1); PG8_STAGE(PG8_SB(1, 0), b3, voffB); PG8_STAGE(PG8_SB(1, 1), b3 + hstep, voffB); PG8_STAGE(PG8_SA(1, 0), a3, vA2);
            PG8_WAIT_V(8); PG8_WAIT_L(0); PG8_BAR; PG8_MMA(1, 0, At, B0); PG8_MMA(1, 1, At, B1); PG8_BAR; PG8_SCHED;
            } else {
            PG8_LDB(B0, 0, 0); PG8_SCHED; PG8_LDA(At, 0, 0); PG8_STAGE(PG8_SA(1, 1), a1 + hstep, voffA);
            PG8_WAIT_L(8); PG8_BAR; PG8_WAIT_L(0); PG8_MMA(0, 0, At, B0); PG8_BAR; PG8_SCHED;
            PG8_LDB(B1, 0, 1); PG8_STAGE(PG8_SB(0, 0), b2, voffB);
            PG8_BAR; PG8_WAIT_L(0); PG8_MMA(0, 1, At, B1); PG8_BAR;
            PG8_LDA(At, 0, 1); PG8_STAGE(PG8_SA(0, 0), a2, voffA);
            PG8_BAR; PG8_WAIT_L(0); PG8_MMA(1, 0, At, B0); PG8_BAR; PG8_SCHED;
            PG8_STAGE(PG8_SB(0, 1), b2 + hstep, voffB);
            PG8_WAIT_V(6); PG8_BAR; PG8_MMA(1, 1, At, B1); PG8_BAR;
            PG8_LDB(B0, 1, 0); PG8_SCHED; PG8_LDA(At, 1, 0); PG8_STAGE(PG8_SA(0, 1), a2 + hstep, voffA);
            PG8_WAIT_L(8); PG8_BAR; PG8_WAIT_L(0); PG8_MMA(0, 0, At, B0); PG8_BAR; PG8_SCHED;
            PG8_LDB(B1, 1, 1); PG8_STAGE(PG8_SB(1, 0), b3, voffB);
            PG8_BAR; PG8_WAIT_L(0); PG8_MMA(0, 1, At, B1); PG8_BAR;
            PG8_LDA(At, 1, 1); PG8_STAGE(PG8_SA(1, 0), a3, voffA);
            PG8_BAR; PG8_WAIT_L(0); PG8_MMA(1, 0, At, B0); PG8_BAR; PG8_SCHED;
            PG8_STAGE(PG8_SB(1, 1), b3 + hstep, voffB);
            PG8_WAIT_V(6); PG8_BAR; PG8_MMA(1, 1, At, B1); PG8_BAR;
            }
        }
        if constexpr (ALIGN_EPI) { if (wr == 0) PG8_BAR; }
        E(acc, cur, wr, wc, fr, fq, lds, wid, lane); S.done(cur);
        if (!has_next) break;
        if (!E.keep(cur))
#pragma unroll
        for (int a = 0; a < 2; ++a)
#pragma unroll
            for (int b = 0; b < 2; ++b)
#pragma unroll
                for (int m = 0; m < 4; ++m)
#pragma unroll
                    for (int n = 0; n < 2; ++n) acc[a][b][m][n] = (f32x4){0.f, 0.f, 0.f, 0.f};
        cur = nxt; cA = nA; cB = nB; ++ui;
        if constexpr (ALIGN_EPI) { if (wr == 1) PG8_BAR; }
    }
    PG8_WAIT_V(0);
    if constexpr (!ALIGN_EPI) { if (wr == 0) PG8_BAR; }
    PG8_BAR;
#undef PG8_ABASE
#undef PG8_SA
#undef PG8_SB
#undef PG8_STAGE
#undef PG8_LDA
#undef PG8_LDB
#undef PG8_MMA
#undef PG8_WAIT_V
#undef PG8_WAIT_L
#undef PG8_BAR
#undef PG8_SCHED
}
}

#define GAS __attribute__((address_space(1)))
#define LAS __attribute__((address_space(3)))
typedef GAS unsigned gu32;
typedef GAS unsigned long long gu64;
#define RLX_AGENT __ATOMIC_RELAXED, __HIP_MEMORY_SCOPE_AGENT
#define LDS_WAIT() asm volatile("s_waitcnt lgkmcnt(0)" ::: "memory")
#define VM_WAIT() asm volatile("s_waitcnt vmcnt(0)" ::: "memory")

#define XB_TMO      128
#define XB_XCNT(j)  (256  + 64 * (j))
#define XB_XSUB(j)  (1280 + 64 * (j))
#define XB_XGEN(j)  (2304 + 64 * (j))
#define XB_TOP      3328
#define XB_TOPGEN   3392
#define XCD_BAR_WORDS 3456
#define XB_SPIN_CAP (1u << 18)

__device__ __forceinline__ unsigned xb_ld(unsigned* p)              { return __hip_atomic_load(p, __ATOMIC_RELAXED, __HIP_MEMORY_SCOPE_AGENT); }
__device__ __forceinline__ unsigned xb_add(unsigned* p, unsigned v) { return __hip_atomic_fetch_add(p, v, __ATOMIC_RELAXED, __HIP_MEMORY_SCOPE_AGENT); }
__device__ __forceinline__ unsigned xb_xcc_id() { return (unsigned)__builtin_amdgcn_s_getreg((3 << 11) | 20) & 0xFu; }
#define XB_SPIN(cond, bar) do { unsigned _sp = 0; while (cond) { __builtin_amdgcn_s_sleep(1); \
    if ((++_sp & 255u) == 0u) { if (xb_ld(&(bar)[XB_TMO])) break; if (_sp > XB_SPIN_CAP) { atomicAdd(&(bar)[XB_TMO], 1u); break; } } } } while (0)

struct XcdBarrier {
    unsigned* bar; unsigned x;
    volatile LAS unsigned* st;
};

__device__ __forceinline__ XcdBarrier xcd_barrier_post(unsigned* bar, volatile LAS unsigned* st, bool leader) {
    XcdBarrier b; b.bar = bar; b.x = xb_xcc_id(); b.st = st;
    if (leader) (void)xb_add(&bar[XB_XCNT(b.x)], 1u);
    return b;
}
__device__ __forceinline__ void xcd_barrier_complete(unsigned* bar, unsigned x, unsigned& nloc, unsigned& nx) {
    const unsigned G = gridDim.x * gridDim.y * gridDim.z;
    unsigned sum, cnt, mine, sp = 0u;
    for (;;) {
        sum = 0u; cnt = 0u; mine = 0u;
#pragma unroll
        for (unsigned j = 0; j < 16; ++j) { const unsigned c = xb_ld(&bar[XB_XCNT(j)]); sum += c; cnt += (c > 0u) ? 1u : 0u; mine = (j == x) ? c : mine; }
        if (sum == G) break;
        __builtin_amdgcn_s_sleep(1);
        if ((++sp & 255u) == 0u) { if (xb_ld(&bar[XB_TMO])) break; if (sp > XB_SPIN_CAP) { atomicAdd(&bar[XB_TMO], 1u); break; } }
    }
    nloc = mine > 0u ? mine : 1u; nx = cnt > 0u ? cnt : 1u;
}

__device__ __forceinline__ void xcd_barrier(const XcdBarrier& b, int wave_) {
    int lane_; asm volatile("v_mbcnt_lo_u32_b32 %0, -1, 0\n\tv_mbcnt_hi_u32_b32 %0, -1, %0" : "=v"(lane_));
    asm volatile("s_waitcnt vmcnt(0)" ::: "memory");
    __syncthreads();
    if (wave_ == 0 && lane_ == 0) {
        unsigned* bar = b.bar;
        __builtin_amdgcn_s_waitcnt(0);
        unsigned nloc = b.st[0], nx = b.st[1];
        if (nloc == 0u) { xcd_barrier_complete(bar, b.x, nloc, nx); b.st[0] = nloc; b.st[1] = nx; }
        const unsigned old = xb_add(&bar[XB_XSUB(b.x)], 1u);
        const unsigned gen = old / nloc;
        if (old + 1u == (gen + 1u) * nloc) {
            __builtin_amdgcn_fence(__ATOMIC_RELEASE, "agent");
            asm volatile("s_waitcnt vmcnt(0)" ::: "memory");
            const unsigned og = xb_add(&bar[XB_TOP], 1u);
            const unsigned tg = og / nx;
            if (og + 1u == (tg + 1u) * nx) xb_add(&bar[XB_TOPGEN], 1u);
            else XB_SPIN(xb_ld(&bar[XB_TOPGEN]) == tg, bar);
            __builtin_amdgcn_fence(__ATOMIC_ACQUIRE, "agent");
            xb_add(&bar[XB_XGEN(b.x)], 1u);
            asm volatile("s_waitcnt vmcnt(0)" ::: "memory");
        } else {
            XB_SPIN(xb_ld(&bar[XB_XGEN(b.x)]) == gen, bar);
            __builtin_amdgcn_fence(__ATOMIC_ACQUIRE, "agent");
            asm volatile("s_waitcnt vmcnt(0)" ::: "memory");
        }
    }
    __syncthreads();
}

__host__ __device__ inline int w1_src_col(int n) { const int pn = n >> 8; if (pn >= 18) { const int sg_ = n & 255; return 4608 + ((sg_ >> 7) ? 1024 : 0) + 128 * (pn - 18) + (sg_ & 127); }
    const bool head = (pn < 4) || (pn >= 6 && pn < 10); if (!head) return n; const int s = n & 255, bj = s >> 7, wc = (s >> 5) & 3, rho = s & 31; return (pn << 8) + 64 * wc + 32 * bj + rho; }
__host__ __device__ inline int w2_src_col(int n) { const int pn = n >> 8, s = n & 255, bj = s >> 7, j = s & 127; return (bj ? DFF : 0) + 128 * pn + j; }
__device__ __forceinline__ float wave_sum(float v) {
#pragma unroll
    for (int o = 1; o < 64; o <<= 1) v += __shfl_xor(v, o);
    return v;
}
__device__ __forceinline__ unsigned pk2(float lo, float hi) { return (unsigned)f2bf(lo) | ((unsigned)f2bf(hi) << 16); }
__device__ __forceinline__ void p0_transpose_item(const float* W, const float* gain, int K, int N, bf16_t* WT, int ldw, int mode, LAS float* scr, int item, int lane) {
    const int nblk = N / 32, kb = item / nblk, nb = item % nblk, k0 = 64 * kb, n0 = 32 * nb;
    const int s0 = mode == 1 ? w1_src_col(n0) : mode == 2 ? w2_src_col(n0) : n0;
    f32x4 wv[8];
#pragma unroll
    for (int i = 0; i < 8; ++i) { const int kk = 8 * i + (lane >> 3); wv[i] = *(const f32x4*)(W + (size_t)(k0 + kk) * N + s0 + 4 * (lane & 7)); }
#pragma unroll
    for (int i = 0; i < 8; ++i) { const int kk = 8 * i + (lane >> 3); const float gk = gain ? gain[k0 + kk] : 1.f; LAS float* d = scr + kk * 33 + 4 * (lane & 7);
        d[0] = wv[i][0] * gk; d[1] = wv[i][1] * gk; d[2] = wv[i][2] * gk; d[3] = wv[i][3] * gk; }
    LDS_WAIT(); asm volatile("" ::: "memory");
    const int c = lane & 7;
#pragma unroll
    for (int j = 0; j < 4; ++j) { const int n = (lane >> 3) + 8 * j; const LAS float* sp = scr + (8 * c) * 33 + n;
        u32x4 o; o.x = pk2(sp[0 * 33], sp[1 * 33]); o.y = pk2(sp[2 * 33], sp[3 * 33]); o.z = pk2(sp[4 * 33], sp[5 * 33]); o.w = pk2(sp[6 * 33], sp[7 * 33]);
        *(u32x4*)(WT + (size_t)(n0 + n) * ldw + k0 + 8 * c) = o; }
    LDS_WAIT(); asm volatile("" ::: "memory");
}
namespace sba {
typedef float f32x16 __attribute__((ext_vector_type(16)));
typedef short s16x4 __attribute__((ext_vector_type(4)));
typedef short v4i16_t __attribute__((ext_vector_type(4)));
constexpr int VREG = 4096;
constexpr int WAVE_LDS = 4 * VREG;
__device__ __forceinline__ int crow(int r, int hi) { return (r & 3) + 8 * (r >> 2) + 4 * hi; }
__device__ __forceinline__ s16x4 vtr(const LAS unsigned char* p) { return __builtin_bit_cast(s16x4, __builtin_amdgcn_ds_read_tr16_b64_v4i16((LAS v4i16_t*)p)); }

template <bool B> struct BoolC { static constexpr bool value = B; };
__device__ __forceinline__ float smul_(float a, float b) { float r; asm volatile("v_mul_f32 %0, %1, %2" : "=v"(r) : "v"(a), "v"(b)); return r; }
#define SMUL(a_, b_) smul_((a_), (b_))
__device__ __forceinline__ void attn_item(int item, const bf16_t* Q, const bf16_t* Kk, const bf16_t* V, bf16_t* Y, LAS unsigned char* vl, int lane) {
    const int r32 = lane & 31, hi = lane >> 5;
    const int qb = item & 63, h = (item >> 6) & 7, b = item >> 9;
    const int t0 = qb * 32; const size_t rowbase = (size_t)b * SEQ;
    bf16x8 qf[4];
#pragma unroll
    for (int d0 = 0; d0 < 4; ++d0) qf[d0] = *(const bf16x8*)(Q + (rowbase + t0 + r32) * 512 + h * 64 + d0 * 16 + hi * 8);
    f32x16 o0 = {}, o1 = {};
    float carry = 1.f;
    const int jt = t0 >> 6;
    const int vbase = (4 * hi + ((lane & 15) >> 2)) * 64 + (16 * ((lane >> 4) & 1) + 4 * (lane & 3)) * 2;
    bf16x8 kfA[2][4], kfB[2][4];
#define SBA_LOAD(j_, ib_, kf_) do { const bf16_t* kp_ = Kk + (rowbase + 64 * (j_) + r32) * 512 + h * 64 + hi * 8; const bf16_t* vp_ = V + (rowbase + 64 * (j_) + (lane >> 2)) * 512 + h * 64 + (lane & 3) * 8; \
        _Pragma("unroll") for (int mb_ = 0; mb_ < 2; ++mb_) _Pragma("unroll") for (int d0_ = 0; d0_ < 4; ++d0_) kf_[mb_][d0_] = *(const bf16x8*)(kp_ + (size_t)mb_ * 32 * 512 + d0_ * 16); \
        _Pragma("unroll") for (int mb_ = 0; mb_ < 2; ++mb_) _Pragma("unroll") for (int g_ = 0; g_ < 4; ++g_) \
            __builtin_amdgcn_global_load_lds((const unsigned*)(vp_ + (size_t)g_ * 16 * 512 + mb_ * 32), (LAS unsigned*)(vl + (ib_) * 2 * VREG + mb_ * VREG + g_ * 1024), 16, 0, 0); } while (0)
    int ib = 0;
    SBA_LOAD(jt, 0, kfA);
    auto tile = [&](auto diag_, const int j, bf16x8 (&kf)[2][4], bf16x8 (&kn)[2][4]) -> bool {
        constexpr bool diag = decltype(diag_)::value;
        asm volatile("s_waitcnt vmcnt(0)" ::: "memory");
        f32x16 p0, p1;
        asm("v_mfma_f32_32x32x16_bf16 %0, %1, %2, 0" : "=&v"(p0) : "v"(kf[0][0]), "v"(qf[0]));
        asm("v_mfma_f32_32x32x16_bf16 %0, %1, %2, 0" : "=&v"(p1) : "v"(kf[1][0]), "v"(qf[0]));
#pragma unroll
        for (int d0 = 1; d0 < 4; ++d0) { p0 = __builtin_amdgcn_mfma_f32_32x32x16_bf16(kf[0][d0], qf[d0], p0, 0, 0, 0); p1 = __builtin_amdgcn_mfma_f32_32x32x16_bf16(kf[1][d0], qf[d0], p1, 0, 0, 0); }
        const LAS unsigned char* vcur = vl + ib * 2 * VREG;
        if (j > 0) { SBA_LOAD(j - 1, ib ^ 1, kn); }
        const int qrel = t0 + r32 - 64 * j;
#define PSEL(g_, i_) ((g_) < 4 ? p0[4 * (g_) + (i_)] : p1[4 * ((g_) - 4) + (i_)])
#pragma unroll
        for (int g = 0; g < 8; ++g) {
#pragma unroll
            for (int i = 0; i < 4; ++i) { const int r = 4 * (g & 3) + i; const float sv = g < 4 ? p0[r] : p1[r];
                float e = __builtin_amdgcn_exp2f(sv);
                if (diag) { if (crow(r, hi) + (g < 4 ? 0 : 32) >= qrel) e = 0.f; }
                const float om = __builtin_amdgcn_rcpf(1.f + e);
                if (g < 4) p0[r] = om; else p1[r] = om; } }
        float T[8], ta[8], tb[8];
#pragma unroll
        for (int g = 0; g < 8; ++g) { ta[g] = SMUL(PSEL(g, 0), PSEL(g, 1)); tb[g] = SMUL(PSEL(g, 2), PSEL(g, 3)); }
#pragma unroll
        for (int g = 0; g < 8; ++g) T[g] = SMUL(ta[g], tb[g]);
        float thi_[8], tt[8];
#pragma unroll
        for (int g = 0; g < 8; ++g) { auto rr = __builtin_amdgcn_permlane32_swap(__float_as_uint(T[g]), __float_as_uint(T[g]), false, false);
            thi_[g] = __uint_as_float(rr[1]); tt[g] = SMUL(__uint_as_float(rr[0]), thi_[g]); }
        float base[8]; float R = carry;
#pragma unroll
        for (int g = 7; g >= 0; --g) { const float Rn = SMUL(R, tt[g]); const float rt = SMUL(R, thi_[g]); base[g] = hi ? R : rt; R = Rn; }
        carry = R;
        {   float tq[8], tn[8];
#pragma unroll
            for (int g = 0; g < 8; ++g) tq[g] = base[g];
#pragma unroll
            for (int i = 3; i >= 0; --i) {
#pragma unroll
                for (int g = 0; g < 8; ++g) tn[g] = SMUL(tq[g], PSEL(g, i));
#pragma unroll
                for (int g = 0; g < 8; ++g) { if (g < 4) p0[4 * g + i] = tq[g] - tn[g]; else p1[4 * (g - 4) + i] = tq[g] - tn[g]; tq[g] = tn[g]; } }
        }
#undef PSEL
        bf16x8 pf[4];
#pragma unroll
        for (int s = 0; s < 4; ++s) { u32x4 w;
            if (s < 2) { w.x = cvt_pk_bf16(p0[8 * s], p0[8 * s + 1]); w.y = cvt_pk_bf16(p0[8 * s + 2], p0[8 * s + 3]); w.z = cvt_pk_bf16(p0[8 * s + 4], p0[8 * s + 5]); w.w = cvt_pk_bf16(p0[8 * s + 6], p0[8 * s + 7]); }
            else { const int q = 8 * (s - 2); w.x = cvt_pk_bf16(p1[q], p1[q + 1]); w.y = cvt_pk_bf16(p1[q + 2], p1[q + 3]); w.z = cvt_pk_bf16(p1[q + 4], p1[q + 5]); w.w = cvt_pk_bf16(p1[q + 6], p1[q + 7]); }
            pf[s] = __builtin_bit_cast(bf16x8, w); }
        { const unsigned va = (unsigned)(unsigned long)(vcur + vbase);
          s16x4 t0, t1, t2, t3, t4, t5, t6, t7, t8, t9, t10, t11, t12, t13, t14, t15;
#define SBA_TR(d_, off_) asm volatile("ds_read_b64_tr_b16 %0, %1 offset:" #off_ : "=v"(d_) : "v"(va) : "memory")
#define SBA_LW(n_, a_, b_, c_, d_) asm volatile("s_waitcnt lgkmcnt(" #n_ ")" : "+v"(a_), "+v"(b_), "+v"(c_), "+v"(d_) :: "memory")
#define SBA_PK(lo_, hi_) ((bf16x8){lo_[0], lo_[1], lo_[2], lo_[3], hi_[0], hi_[1], hi_[2], hi_[3]})
          SBA_TR(t0, 0);     SBA_TR(t1, 512);   SBA_TR(t2, 4096);   SBA_TR(t3, 4608);
          SBA_TR(t4, 1024);  SBA_TR(t5, 1536);  SBA_TR(t6, 5120);   SBA_TR(t7, 5632);
          SBA_TR(t8, 2048);  SBA_TR(t9, 2560);  SBA_TR(t10, 6144);  SBA_TR(t11, 6656);
          SBA_TR(t12, 3072); SBA_TR(t13, 3584); SBA_TR(t14, 7168);  SBA_TR(t15, 7680);
          SBA_LW(12, t0, t1, t2, t3);
          o0 = __builtin_amdgcn_mfma_f32_32x32x16_bf16(SBA_PK(t0, t1), pf[0], o0, 0, 0, 0); o1 = __builtin_amdgcn_mfma_f32_32x32x16_bf16(SBA_PK(t2, t3), pf[0], o1, 0, 0, 0);
          SBA_LW(8, t4, t5, t6, t7);
          o0 = __builtin_amdgcn_mfma_f32_32x32x16_bf16(SBA_PK(t4, t5), pf[1], o0, 0, 0, 0); o1 = __builtin_amdgcn_mfma_f32_32x32x16_bf16(SBA_PK(t6, t7), pf[1], o1, 0, 0, 0);
          SBA_LW(4, t8, t9, t10, t11);
          o0 = __builtin_amdgcn_mfma_f32_32x32x16_bf16(SBA_PK(t8, t9), pf[2], o0, 0, 0, 0); o1 = __builtin_amdgcn_mfma_f32_32x32x16_bf16(SBA_PK(t10, t11), pf[2], o1, 0, 0, 0);
          SBA_LW(0, t12, t13, t14, t15);
          o0 = __builtin_amdgcn_mfma_f32_32x32x16_bf16(SBA_PK(t12, t13), pf[3], o0, 0, 0, 0); o1 = __builtin_amdgcn_mfma_f32_32x32x16_bf16(SBA_PK(t14, t15), pf[3], o1, 0, 0, 0);
#undef SBA_TR
#undef SBA_LW
#undef SBA_PK
        }
        ib ^= 1;
        return __all(carry < 7.8886e-31f);
    };
    if (!tile(BoolC<true>{}, jt, kfA, kfB))
        for (int j = jt - 1; j >= 0; j -= 2) { if (tile(BoolC<false>{}, j, kfB, kfA) || j == 0) break; if (tile(BoolC<false>{}, j - 1, kfA, kfB)) break; }
#undef SBA_LOAD
    bf16_t* yp = Y + (rowbase + t0 + r32) * 512 + h * 64 + 4 * hi;
#pragma unroll
    for (int g = 0; g < 4; ++g) { u32x2 w; w.x = cvt_pk_bf16(o0[4 * g], o0[4 * g + 1]); w.y = cvt_pk_bf16(o0[4 * g + 2], o0[4 * g + 3]); *(u32x2*)(yp + 8 * g) = w;
                                  u32x2 x; x.x = cvt_pk_bf16(o1[4 * g], o1[4 * g + 1]); x.y = cvt_pk_bf16(o1[4 * g + 2], o1[4 * g + 3]); *(u32x2*)(yp + 32 + 8 * g) = x; }
}
}

namespace ret {
typedef float f32x16 __attribute__((ext_vector_type(16)));
typedef short s16x4 __attribute__((ext_vector_type(4)));
typedef short v4i16_t __attribute__((ext_vector_type(4)));
constexpr int RSTR = 4096 + 32;
constexpr int KT_BYTES = 16640, VT_BYTES = 33280, SB_PITCH = 144, SB_BYTES = 128 * SB_PITCH;
constexpr int OFF_KT = 0, OFF_VT = 2 * KT_BYTES, OFF_SB = OFF_VT + 2 * VT_BYTES, OFF_G = OFF_SB + SB_BYTES, OFF_X = OFF_G + 512, LDS_TOTAL = OFF_X + 1024;
constexpr int OFF_Q = 132096, Q_BYTES = 128 * SB_PITCH;
__device__ __forceinline__ int crow(int r, int hi) { return (r & 3) + 8 * (r >> 2) + 4 * hi; }
__device__ __forceinline__ s16x4 vtr(const LAS unsigned char* p) { return __builtin_bit_cast(s16x4, __builtin_amdgcn_ds_read_tr16_b64_v4i16((LAS v4i16_t*)p)); }
#define RET_BAR() do { asm volatile("s_waitcnt lgkmcnt(0)" ::: "memory"); __builtin_amdgcn_s_barrier(); asm volatile("" ::: "memory"); } while (0)
#define RET_PK(lo_, hi_) ((bf16x8){lo_[0], lo_[1], lo_[2], lo_[3], hi_[0], hi_[1], hi_[2], hi_[3]})

__device__ __forceinline__ void ret_seq(int bh, const bf16_t* Qr, const bf16_t* Kr, const bf16_t* Vr, const bf16_t* SG, const float* gain, bf16_t* Y, LAS unsigned char* L, int tid) {
    const int lane = tid & 63, w = __builtin_amdgcn_readfirstlane(tid >> 6), r32 = lane & 31, hi = lane >> 5, g16 = (lane >> 4) & 1, i16 = lane & 15;
    const int rb = w < 4 ? (w >> 1) : 3 - ((w >> 1) & 1), eh = w & 1;
    const int b = bh >> 3, h = bh & 7; const size_t rowbase = (size_t)b * SEQ, hmbase = (size_t)bh * SEQ;
    const float gmm = 1.f - exp2f(-5.f - (float)h), lg = log2f(gmm); const float gC = exp2f(lg * 128.f), gC1 = exp2f(lg * 127.f);
    f32x16 S = {};
    u32x4 kreg[2], vreg[4], qreg[2];
#define RET_LOAD(n_) do { const size_t r0_ = hmbase + (size_t)(n_) * 128;     \
        _Pragma("unroll") for (int i_ = 0; i_ < 2; ++i_) { const int c_ = tid + 512 * i_; kreg[i_] = *(const u32x4*)(Kr + (r0_ + (c_ >> 3)) * 64 + (c_ & 7) * 8); qreg[i_] = *(const u32x4*)(Qr + (r0_ + (c_ >> 3)) * 64 + (c_ & 7) * 8); } \
        _Pragma("unroll") for (int i_ = 0; i_ < 4; ++i_) { const int c_ = tid + 512 * i_; vreg[i_] = *(const u32x4*)(Vr + (r0_ + (c_ >> 4)) * 128 + (c_ & 15) * 8); } } while (0)
#define RET_WRITE(buf_) do { \
        _Pragma("unroll") for (int i_ = 0; i_ < 2; ++i_) { const int c_ = tid + 512 * i_, key_ = c_ >> 3, part_ = c_ & 7; *(LAS u32x4*)(L + OFF_KT + (buf_) * KT_BYTES + (part_ >> 1) * RSTR + key_ * 32 + (part_ & 1) * 16) = kreg[i_]; \
            *(LAS u32x4*)(L + OFF_Q + key_ * SB_PITCH + part_ * 16) = qreg[i_]; } \
        _Pragma("unroll") for (int i_ = 0; i_ < 4; ++i_) { const int c_ = tid + 512 * i_, key_ = c_ >> 4, part_ = c_ & 15; *(LAS u32x4*)(L + OFF_VT + (buf_) * VT_BYTES + (part_ >> 1) * RSTR + key_ * 32 + (part_ & 1) * 16) = vreg[i_]; } } while (0)
    RET_LOAD(0);
    for (int i = tid; i < SB_BYTES / 4; i += 512) ((LAS unsigned*)(L + OFF_SB))[i] = 0u;
    if (tid < 128) ((LAS float*)(L + OFF_G))[tid] = gain[h * 128 + tid];
    RET_WRITE(0);
    const int troff = (4 * hi + (i16 >> 2)) * 32 + (i16 & 3) * 8;
    const size_t qrow0 = rowbase + 32 * rb + r32;
    RET_BAR();
    for (int n = 0; n < 16; ++n) {
        const int buf = n & 1; const LAS unsigned char* Kt = L + OFF_KT + buf * KT_BYTES; const LAS unsigned char* Vt = L + OFF_VT + buf * VT_BYTES;
        const size_t qrow = qrow0 + (size_t)n * 128;
        u32x2 sgv[8];
#pragma unroll
        for (int q = 0; q < 8; ++q) sgv[q] = *(const u32x2*)(SG + (hmbase + (size_t)n * 128 + 32 * rb + r32) * 128 + 64 * eh + 32 * (q >> 2) + 8 * (q & 3) + 4 * hi);
        bf16x8 qf[4];
#pragma unroll
        for (int ks = 0; ks < 4; ++ks) qf[ks] = *(const LAS bf16x8*)(L + OFF_Q + (32 * rb + r32) * SB_PITCH + (16 * ks + 8 * hi) * 2);
        const int nn = n < 15 ? n + 1 : 15;
        RET_LOAD(nn);
        f32x16 y0 = {}, y1 = {};
#pragma unroll
        for (int kb = 0; kb < 4; ++kb) if (kb <= rb) {
            bf16x8 ka[4];
#pragma unroll
            for (int ks = 0; ks < 4; ++ks) ka[ks] = *(const LAS bf16x8*)(Kt + ks * RSTR + (32 * kb + r32) * 32 + hi * 16);
            s16x4 vl0[2][2], vh0[2][2];
#pragma unroll
            for (int s = 0; s < 2; ++s)
#pragma unroll
                for (int eb = 0; eb < 2; ++eb) { const LAS unsigned char* vp = Vt + (4 * eh + 2 * eb + g16) * RSTR + (32 * kb + 16 * s) * 32 + troff; vl0[s][eb] = vtr(vp); vh0[s][eb] = vtr(vp + 8 * 32); }
            __builtin_amdgcn_sched_barrier(0);
            f32x16 in = {};
#pragma unroll
            for (int ks = 0; ks < 4; ++ks) in = __builtin_amdgcn_mfma_f32_32x32x16_bf16(ka[ks], qf[ks], in, 0, 0, 0);
            if (kb == rb) {
#pragma unroll
                for (int r = 0; r < 16; ++r) if (crow(r, hi) > r32) in[r] = 0.f; }
#pragma unroll
            for (int s = 0; s < 2; ++s) { u32x4 pw; pw.x = cvt_pk_bf16(in[8 * s], in[8 * s + 1]); pw.y = cvt_pk_bf16(in[8 * s + 2], in[8 * s + 3]); pw.z = cvt_pk_bf16(in[8 * s + 4], in[8 * s + 5]); pw.w = cvt_pk_bf16(in[8 * s + 6], in[8 * s + 7]);
                const bf16x8 pf = __builtin_bit_cast(bf16x8, pw);
                y0 = __builtin_amdgcn_mfma_f32_32x32x16_bf16(RET_PK(vl0[s][0], vh0[s][0]), pf, y0, 0, 0, 0);
                y1 = __builtin_amdgcn_mfma_f32_32x32x16_bf16(RET_PK(vl0[s][1], vh0[s][1]), pf, y1, 0, 0, 0); }
            __builtin_amdgcn_sched_barrier(0);
        }
        { bf16x8 sa[2][4];
#pragma unroll
          for (int eb = 0; eb < 2; ++eb)
#pragma unroll
              for (int ks = 0; ks < 4; ++ks) sa[eb][ks] = *(const LAS bf16x8*)(L + OFF_SB + (64 * eh + 32 * eb + r32) * SB_PITCH + (16 * ks + 8 * hi) * 2);
          __builtin_amdgcn_sched_barrier(0);
#pragma unroll
          for (int ks = 0; ks < 4; ++ks) { y0 = __builtin_amdgcn_mfma_f32_32x32x16_bf16(sa[0][ks], qf[ks], y0, 0, 0, 0); y1 = __builtin_amdgcn_mfma_f32_32x32x16_bf16(sa[1][ks], qf[ks], y1, 0, 0, 0); }
          __builtin_amdgcn_sched_barrier(0); }
        { float ss = 0.f;
#pragma unroll
          for (int r = 0; r < 16; ++r) ss += y0[r] * y0[r] + y1[r] * y1[r];
          auto rr = __builtin_amdgcn_permlane32_swap(__float_as_uint(ss), __float_as_uint(ss), false, false); ss = __uint_as_float(rr[0]) + __uint_as_float(rr[1]);
          if (hi == 0) ((LAS float*)(L + OFF_X))[(32 * rb + r32) * 2 + eh] = ss; }
        f32x16 U = {};
#pragma unroll
        for (int s2 = 0; s2 < 4; ++s2) {
            s16x4 al[2], ah[2], bl[2], bh_[2];
#pragma unroll
            for (int q = 0; q < 2; ++q) { const int s = 2 * s2 + q; const LAS unsigned char* ap = Vt + (2 * (w >> 1) + g16) * RSTR + (16 * s) * 32 + troff; const LAS unsigned char* bp = Kt + (2 * (w & 1) + g16) * RSTR + (16 * s) * 32 + troff;
                al[q] = vtr(ap); ah[q] = vtr(ap + 8 * 32); bl[q] = vtr(bp); bh_[q] = vtr(bp + 8 * 32); }
            __builtin_amdgcn_sched_barrier(0);
#pragma unroll
            for (int q = 0; q < 2; ++q) U = __builtin_amdgcn_mfma_f32_32x32x16_bf16(RET_PK(al[q], ah[q]), RET_PK(bl[q], bh_[q]), U, 0, 0, 0);
            __builtin_amdgcn_sched_barrier(0);
        }
        RET_BAR();
        RET_WRITE(buf ^ 1);
        { const float tot = ((const LAS float*)(L + OFF_X))[(32 * rb + r32) * 2] + ((const LAS float*)(L + OFF_X))[(32 * rb + r32) * 2 + 1];
          const float rs = 1.0f / sqrtf(tot * (1.f / 128.f) + EPS);
#pragma unroll
          for (int q = 0; q < 8; ++q) { const int eb = q >> 2, g = q & 3, e0 = 64 * eh + 32 * eb + 8 * g + 4 * hi; const u32x2 sg = sgv[q];
              const f32x4 gv = *(const LAS f32x4*)(L + OFF_G + e0 * 4);
              float o0, o1, o2, o3;
              if (eb == 0) { o0 = y0[4 * g]; o1 = y0[4 * g + 1]; o2 = y0[4 * g + 2]; o3 = y0[4 * g + 3]; } else { o0 = y1[4 * g]; o1 = y1[4 * g + 1]; o2 = y1[4 * g + 2]; o3 = y1[4 * g + 3]; }
              u32x2 wv; wv.x = cvt_pk_bf16(o0 * gv[0] * rs * __builtin_bit_cast(float, sg.x << 16), o1 * gv[1] * rs * __builtin_bit_cast(float, sg.x & 0xffff0000u));
              wv.y = cvt_pk_bf16(o2 * gv[2] * rs * __builtin_bit_cast(float, sg.y << 16), o3 * gv[3] * rs * __builtin_bit_cast(float, sg.y & 0xffff0000u));
              *(u32x2*)(Y + qrow * 1024 + h * 128 + e0) = wv; } }
#pragma unroll
        for (int r = 0; r < 16; ++r) { S[r] = S[r] * gC + U[r] * gC1;
            *(LAS bf16_t*)(L + OFF_SB + (32 * (w >> 1) + crow(r, hi)) * SB_PITCH + (32 * (w & 1) + r32) * 2) = f2bf(S[r] * gmm); }
        RET_BAR();
    }
#undef RET_LOAD
#undef RET_WRITE
}
}

constexpr int RING_OFF = 0, RING_BYTES = 131072;
constexpr int LDSCTL_OFF = RING_BYTES, MISC_OFF = LDSCTL_OFF + 320;
constexpr int EPI_OFF = RING_BYTES + 1024;
constexpr int LDS_BYTES = 160 * 1024;
constexpr int NWAVES = 8;
constexpr int CW_TMO = 0, CW_CODE = 1, CW_BAR = 4096, CW_ATT = 49152;
constexpr int MAX_BAR_REGIONS = 12;
static_assert(CW_BAR + MAX_BAR_REGIONS * XCD_BAR_WORDS <= CW_ATT && (CW_ATT + MAX_BAR_REGIONS * 8 * 64) * 4 <= (int)CTL_ZERO_BYTES, "CTL words inside the memset region");

struct Args { const float* in[18]; float* out; unsigned char* ws; int ph_lo, ph_hi, li, pad; };

__global__ void __launch_bounds__(NWAVES * 64, 2) mk_fwd(Args args) {
    extern __shared__ __attribute__((aligned(16))) unsigned char lds_raw[];
    LAS unsigned char* lds = (LAS unsigned char*)lds_raw;
    volatile LAS unsigned* MISC = (volatile LAS unsigned*)(lds + MISC_OFF);
    const int wave = __builtin_amdgcn_readfirstlane((int)threadIdx.x >> 6);
#define FRESH_LANE() ({ int l_; asm volatile("v_mbcnt_lo_u32_b32 %0, -1, 0\n\tv_mbcnt_hi_u32_b32 %0, -1, %0" : "=v"(l_)); l_; })
    const int G = gridDim.x;
    unsigned char* ws = args.ws;
    gu32* ctl = (gu32*)(ws + WS_CTL);
    for (int u = (int)threadIdx.x; u < 1024 / 4; u += NWAVES * 64) ((LAS unsigned*)(lds + LDSCTL_OFF))[u] = 0u;
    __syncthreads();
    XcdBarrier bar = xcd_barrier_post((unsigned*)(ctl + CW_BAR) + args.li * XCD_BAR_WORDS, MISC + 8, threadIdx.x == 0);
    const int lo = args.ph_lo, hi = args.ph_hi;
#ifndef PHASE_MASK
#define PHASE_MASK 0x1ff
#endif
#define IN(k) (((PHASE_MASK >> (k)) & 1) && lo <= (k) && (k) < hi)
#define BOTH(k) (IN(k) && IN((k) + 1))
    float* out = args.out;
    const float* x = args.in[0];

#ifdef VPROBE
    {
        typedef float f2_ __attribute__((ext_vector_type(2)));
        f2_ r[16]; const float kk = 1.0000001f; const f2_ k2 = {kk, kk};
#pragma unroll
        for (int j = 0; j < 16; ++j) { r[j][0] = (float)(threadIdx.x + j); r[j][1] = (float)(threadIdx.x + 2 * j); }
        for (int it = 0; it < 20000; ++it) {
#pragma unroll
            for (int j = 0; j < 16; ++j) {
#if VPROBE == 1
                asm volatile("v_pk_mul_f32 %0, %0, %1" : "+v"(r[j]) : "v"(k2));
#elif VPROBE == 2
                asm volatile("v_mul_f32 %0, %0, %1" : "+v"(r[j][0]) : "v"(kk)); asm volatile("v_mul_f32 %0, %0, %1" : "+v"(r[j][1]) : "v"(kk));
#elif VPROBE == 3
                asm volatile("v_pk_fma_f32 %0, %0, %1, %1" : "+v"(r[j]) : "v"(k2));
#elif VPROBE == 4
                asm volatile("v_exp_f32 %0, %0" : "+v"(r[j][0])); asm volatile("v_rcp_f32 %0, %0" : "+v"(r[j][1]));
#endif
            }
        }
        float s = 0.f;
#pragma unroll
        for (int j = 0; j < 16; ++j) s += r[j][0] + r[j][1];
        if (s == 12345.678f) args.out[0] = s;
    }
#endif
    if (IN(0)) {
        const int lane = FRESH_LANE(), tid = wave * 64 + lane;
        LAS float* scr = (LAS float*)(lds + RING_OFF + wave * 16384);
        const int gw = (int)blockIdx.x * NWAVES + wave, NGW = G * NWAVES;
        constexpr int I1 = (DM / 64) * (DIN / 32), IA = (512 / 64) * (DM / 32), IB = (DM / 64) * (DM / 32), IO = IB, I2 = (DM / 64) * (2 * DFF / 32), I3 = (DFF / 64) * (DM / 32), IG = IB, IP = (PLE / 64) * (DM / 32);
        constexpr int NITEMS = I1 + IA + IB + IO + I2 + I3 + IG + IP;
        for (int it = gw; it < NITEMS; it += NGW) {
            int r = it;
            if (r < I1) { p0_transpose_item(args.in[3], args.in[2], DM, DIN, (bf16_t*)(ws + WS_W1), DM, 1, scr, r, lane); continue; } r -= I1;
            if (r < IA) { p0_transpose_item(args.in[7], nullptr, 512, DM, (bf16_t*)(ws + WS_WAB), 1536, 0, scr, r, lane); continue; } r -= IA;
            if (r < IB) { p0_transpose_item(args.in[8], nullptr, DM, DM, (bf16_t*)(ws + WS_WAB) + 512, 1536, 0, scr, r, lane); continue; } r -= IB;
            if (r < IO) { p0_transpose_item(args.in[9], nullptr, DM, DM, (bf16_t*)(ws + WS_WO), DM, 0, scr, r, lane); continue; } r -= IO;
            if (r < I2) { p0_transpose_item(args.in[11], args.in[10], DM, 2 * DFF, (bf16_t*)(ws + WS_W2), DM, 2, scr, r, lane); continue; } r -= I2;
            if (r < I3) { p0_transpose_item(args.in[14], nullptr, DFF, DM, (bf16_t*)(ws + WS_W3), DFF, 0, scr, r, lane); continue; } r -= I3;
            if (r < IG) { p0_transpose_item(args.in[16], args.in[15], DM, DM, (bf16_t*)(ws + WS_WPG), DM, 0, scr, r, lane); continue; } r -= IG;
            p0_transpose_item(args.in[17], nullptr, PLE, DM, (bf16_t*)(ws + WS_WPP), PLE, 0, scr, r, lane);
        }
        for (int m0 = gw * 4; m0 < M; m0 += NGW * 4) {
            f32x4 v[4][4];
#pragma unroll
            for (int r = 0; r < 4; ++r) { const f32x4* xr = (const f32x4*)(x + (size_t)(m0 + r) * DM) + lane;
#pragma unroll
                for (int j = 0; j < 4; ++j) v[r][j] = xr[64 * j]; }
#pragma unroll
            for (int r = 0; r < 4; ++r) { float ss = 0.f;
#pragma unroll
                for (int j = 0; j < 4; ++j) ss += (v[r][j][0] * v[r][j][0] + v[r][j][1] * v[r][j][1]) + (v[r][j][2] * v[r][j][2] + v[r][j][3] * v[r][j][3]);
                ss = wave_sum(ss);
                if (lane == 0) ((float*)(ws + WS_RSTD0))[m0 + r] = 1.0f / sqrtf(ss * (1.f / DM) + EPS);
                u32x2* o8 = (u32x2*)((bf16_t*)out + (size_t)(m0 + r) * DM) + lane;
#pragma unroll
                for (int j = 0; j < 4; ++j) { u32x2 w; w.x = pk2(v[r][j][0], v[r][j][1]); w.y = pk2(v[r][j][2], v[r][j][3]); o8[64 * j] = w; } }
        }
        { const f32x4* p4 = (const f32x4*)args.in[1]; u32x2* o = (u32x2*)(ws + WS_PB);
          const int T = G * NWAVES * 64;
          for (int i = (int)blockIdx.x * (NWAVES * 64) + tid; i < M * PLE / 4; i += 4 * T) { f32x4 v[4];
#pragma unroll
              for (int q = 0; q < 4; ++q) v[q] = p4[i + q * T];
#pragma unroll
              for (int q = 0; q < 4; ++q) { u32x2 w; w.x = pk2(v[q][0], v[q][1]); w.y = pk2(v[q][2], v[q][3]); o[i + q * T] = w; } } }
        { float* rope = (float*)(ws + WS_ROPE);
          for (int i = (int)blockIdx.x * (NWAVES * 64) + tid; i < SEQ * 32; i += G * NWAVES * 64) { const int t = i >> 5, j = i & 31;
              const float inv = powf(10000.f, -(float)j * (2.0f / 64.f)); float sn, cs; sincosf((float)t * inv, &sn, &cs); rope[i] = cs; rope[SEQ * 32 + i] = sn; } }
        if (BOTH(0)) xcd_barrier(bar, wave);
    }
    if (IN(1)) {
        { pg8::Gemm g{(const bf16_t*)out  , (const bf16_t*)(ws + WS_W1) + (size_t)18 * 256 * DM, M, 8 * 256, DM}; pg8::StaticOrder S; S.init(M, 8 * 256, G, (int)blockIdx.x); S.ntk = DM / 64;
          pg8::EpProj E{18, 0, (const float*)(ws + WS_RSTD0), ws, args.in[4], args.in[5], (const float*)(ws + WS_ROPE)};
          pg8::gemm_phase<pg8::EpProj, pg8::StaticOrder, true, true>(lds + RING_OFF, g, S, E, wave); }
        { pg8::Gemm g{(const bf16_t*)out, (const bf16_t*)(ws + WS_W1), M, 18 * 256, DM}; pg8::StaticOrder S; S.init(M, 18 * 256, G, (int)blockIdx.x); S.ntk = DM / 64;
          pg8::EpProj E{0, 0, (const float*)(ws + WS_RSTD0), ws, args.in[4], args.in[5], (const float*)(ws + WS_ROPE)};
          pg8::gemm_phase<pg8::EpProj, pg8::StaticOrder, true, true>(lds + RING_OFF, g, S, E, wave); }
        if (BOTH(1)) xcd_barrier(bar, wave);
    }
    if (IN(2)) {
        const bf16_t* Q = (const bf16_t*)(ws + WS_QSB); const bf16_t* Kk = (const bf16_t*)(ws + WS_KSB); const bf16_t* V = (const bf16_t*)(ws + WS_VSB);
        bf16_t* Ysb = (bf16_t*)(ws + WS_QSB);
        bf16_t* Yr = (bf16_t*)out + (size_t)M * DM;
        if (((blockIdx.x >> 3) & 1) == 0 && !(args.pad & 4)) {
            const int bh = ((int)blockIdx.x >> 4) * 8 + ((int)blockIdx.x & 7);
            if (bh < NB * 8) ret::ret_seq(bh, (const bf16_t*)(ws + WS_QR), (const bf16_t*)(ws + WS_KR), (const bf16_t*)(ws + WS_VR), (const bf16_t*)(ws + WS_SGR), args.in[6], Yr, lds + RING_OFF, wave * 64 + FRESH_LANE());
        }
        if (!(args.pad & 8)) {
            const int lane = FRESH_LANE();
            LAS unsigned char* vl = lds + RING_OFF + wave * sba::WAVE_LDS;
            const int shard = (int)blockIdx.x & 7; gu32* ctr = ctl + CW_ATT + (args.li * 8 + shard) * 64;
            int nxt_it = -1;
            for (;;) {
                int it2 = nxt_it; if (it2 < 0) { if (lane == 0) it2 = (int)__hip_atomic_fetch_add(ctr, 1u, __ATOMIC_RELAXED, __HIP_MEMORY_SCOPE_AGENT); }
                it2 = __builtin_amdgcn_readfirstlane(it2);
                if (it2 >= 1024) break;
                int nx_raw = 0; if (lane == 0) { const int one_ = 1; asm volatile("global_atomic_add %0, %1, %2, off sc0" : "=v"(nx_raw) : "v"(ctr), "v"(one_) : "memory"); }
                sba::attn_item(shard * 1024 + it2, Q, Kk, V, Ysb, vl, lane);
                asm volatile("" : "+v"(nx_raw));
                nxt_it = nx_raw;
            }
            __syncthreads();
        }
        if (BOTH(2)) xcd_barrier(bar, wave);
    }
    if (IN(3)) {
        pg8::Gemm g{(const bf16_t*)out + (size_t)M * DM  , (const bf16_t*)(ws + WS_WAB), M, DM, 1536, DM, (const bf16_t*)(ws + WS_QSB)  , 512, 0}; pg8::PairOrder S; S.base.init(M, DM, G, (int)blockIdx.x); S.base.ntk = 0;
        pg8::EpMerged E{0, 0, (const bf16_t*)(ws + WS_SA), (bf16_t*)(ws + WS_SB)};
        pg8::gemm_phase<pg8::EpMerged, pg8::PairOrder, true, true, true>(lds + RING_OFF, g, S, E, wave);
        if (BOTH(3)) xcd_barrier(bar, wave);
    }
    if (IN(4)) {
        if (!(args.pad & 2)) { pg8::Gemm g{(const bf16_t*)(ws + WS_MERGED), (const bf16_t*)(ws + WS_WO), M, DM, DM}; pg8::StaticOrder S; S.init(M, DM, G, (int)blockIdx.x); S.ntk = DM / 64;
          pg8::EpResid<true> E{0, 0, (const void*)out  , (bf16_t*)(ws + WS_X1B), (float*)(ws + WS_PART1)};
          pg8::gemm_phase<pg8::EpResid<true>, pg8::StaticOrder, true, true>(lds + RING_OFF, g, S, E, wave); }
        if (BOTH(4)) xcd_barrier(bar, wave);
    }
    if (IN(5)) {
        pg8::Gemm g{(const bf16_t*)(ws + WS_X1B), (const bf16_t*)(ws + WS_W2), M, 2 * DFF, DM}; pg8::StaticOrder S; S.init(M, 2 * DFF, G, (int)blockIdx.x); S.ntk = DM / 64;
        pg8::Unit u0; (void)S.next(0, u0);
        {
            const int tid = wave * 64 + FRESH_LANE(); LAS float* tab = (LAS float*)(lds + EPI_OFF + 4096); pg8::Unit fu; int prev_pm = -1, slot = 0;
            for (int i = 0; S.next(i, fu); ++i) { if (fu.pm == prev_pm) continue; prev_pm = fu.pm; slot = (fu.pm - u0.pm) / pg8::WGM;
                if (tid < 256 && slot < 8) tab[slot * 256 + tid] = rstd_part((const float*)(ws + WS_PART1), fu.pm * 256 + tid); }
            __syncthreads();
        }
        pg8::EpUp E{u0.pm, pg8::WGM, (const float*)(ws + WS_PART1), args.in[12], args.in[13], (bf16_t*)(ws + WS_ACT), (float*)(ws + WS_HALO)};
        pg8::gemm_phase<pg8::EpUp, pg8::StaticOrder, true, true>(lds + RING_OFF, g, S, E, wave);
        if (BOTH(5)) xcd_barrier(bar, wave);
    }
    if (IN(7)) {
        pg8::Gemm g{(const bf16_t*)(ws + WS_ACT), (const bf16_t*)(ws + WS_W3), M, DM, DFF}; pg8::StaticOrder S; S.init(M, DM, G, (int)blockIdx.x); S.ntk = DFF / 64;
        {   const int tid = wave * 64 + FRESH_LANE();
            const float* halo = (const float*)(ws + WS_HALO); const float* cw = args.in[12]; const float* cb = args.in[13]; bf16_t* act = (bf16_t*)(ws + WS_ACT);
            pg8::Unit fu; int pms[2] = {-1, -1}; int npm = 0;
            for (int i = 0; S.next(i, fu); ++i) { if (npm > 0 && fu.pm == pms[npm - 1]) continue; if (npm < 2) pms[npm++] = fu.pm; }
            constexpr int C4 = DFF / 4;
            const int nitems = npm * 2 * C4;
#pragma unroll 1
            for (int base = tid; base < nitems; base += 2 * NWAVES * 64) {
                f32x4 a0v[2], u0v[2], l0v[2], l1v[2], f0v[2], w0v[2], w1v[2], w2v[2], bbv[2]; int pmv[2], jv[2], chv[2]; bool ok[2];
#pragma unroll
                for (int q = 0; q < 2; ++q) { const int idx = base + q * NWAVES * 64; ok[q] = idx < nitems; const int id = ok[q] ? idx : 0;
                    const int slot = id / (2 * C4), rem = id % (2 * C4), j = rem / C4, ch = 4 * (rem % C4), pm = slot ? pms[1] : pms[0]; pmv[q] = pm; jv[q] = j; chv[q] = ch;
                    const int pmp = (pm & 7) ? pm - 1 : pm;
                    a0v[q] = *(const f32x4*)(halo + HALO_ELEMS + ((size_t)pm * 2 + j) * DFF + ch); u0v[q] = *(const f32x4*)(halo + 2 * HALO_ELEMS + ((size_t)pm * 2 + j) * DFF + ch);
                    f0v[q] = *(const f32x4*)(halo + HALO_ELEMS + ((size_t)pm * 2) * DFF + ch);
                    l0v[q] = *(const f32x4*)(halo + ((size_t)pmp * 2) * DFF + ch); l1v[q] = *(const f32x4*)(halo + ((size_t)pmp * 2 + 1) * DFF + ch);
                    w0v[q] = *(const f32x4*)(cw + ch); w1v[q] = *(const f32x4*)(cw + DFF + ch); w2v[q] = *(const f32x4*)(cw + 2 * DFF + ch); bbv[q] = *(const f32x4*)(cb + ch); }
#pragma unroll
                for (int q = 0; q < 2; ++q) if (ok[q]) { const bool first = (pmv[q] & 7) == 0; const f32x4 z = {0.f, 0.f, 0.f, 0.f};
                    const f32x4 L0 = first ? z : l0v[q], L1 = first ? z : l1v[q];
                    const f32x4 p1 = jv[q] ? f0v[q] : L1, p2 = jv[q] ? L1 : L0;
                    const f32x4 c = bbv[q] + w0v[q] * p2 + w1v[q] * p1 + w2v[q] * a0v[q];
                    u32x2 w; w.x = cvt_pk_bf16(fast_gelu(c[0]) * u0v[q][0], fast_gelu(c[1]) * u0v[q][1]); w.y = cvt_pk_bf16(fast_gelu(c[2]) * u0v[q][2], fast_gelu(c[3]) * u0v[q][3]);
                    *(u32x2*)(act + ((size_t)pmv[q] * 256 + jv[q]) * DFF + chv[q]) = w; }
            }
            asm volatile("s_waitcnt vmcnt(0)" ::: "memory"); __syncthreads();
        }
        pg8::EpResid<true> E{0, 0, (const void*)(ws + WS_X1B), (bf16_t*)(ws + WS_X2B), (float*)(ws + WS_PART2)};
        pg8::gemm_phase<pg8::EpResid<true>, pg8::StaticOrder, true, true>(lds + RING_OFF, g, S, E, wave);
        {
            pg8::Gemm gp{(const bf16_t*)(ws + WS_PB), (const bf16_t*)(ws + WS_WPP), M, DM, PLE}; pg8::StaticOrder Sp; Sp.init(M, DM, G, (int)blockIdx.x); Sp.ntk = PLE / 64;
            pg8::EpStore Ep{0, DM, (bf16_t*)(ws + WS_PP2)};
            pg8::gemm_phase<pg8::EpStore, pg8::StaticOrder, true, true>(lds + RING_OFF, gp, Sp, Ep, wave); }
        if (BOTH(7)) xcd_barrier(bar, wave);
    }
    if (IN(8)) {
        pg8::Gemm g{(const bf16_t*)(ws + WS_X2B), (const bf16_t*)(ws + WS_WPG), M, DM, DM}; pg8::StaticOrder S; S.init(M, DM, G, (int)blockIdx.x); S.ntk = DM / 64;
        pg8::Unit u0; (void)S.next(0, u0);
        {
            const int tid = wave * 64 + FRESH_LANE(); LAS float* tab = (LAS float*)(lds + EPI_OFF + 4096); pg8::Unit fu; int prev_pm = -1;
            for (int i = 0; S.next(i, fu); ++i) { if (fu.pm == prev_pm) continue; prev_pm = fu.pm; const int slot = (fu.pm - u0.pm) / pg8::WGM;
                if (tid < 256 && slot < 8) tab[slot * 256 + tid] = rstd_part((const float*)(ws + WS_PART2), fu.pm * 256 + tid); }
            __syncthreads();
        }
        pg8::EpFinalP E{u0.pm, pg8::WGM, (const float*)(ws + WS_PART2), (const bf16_t*)(ws + WS_PP2), (const bf16_t*)(ws + WS_X2B), out};
        pg8::gemm_phase<pg8::EpFinalP, pg8::StaticOrder, true, true>(lds + RING_OFF, g, S, E, wave);
    }
#undef IN
#undef BOTH
}

extern "C" void kernel_launch(void* const* d_in, const int* in_sizes, int n_in, void* d_out, int out_size, void* d_ws, size_t ws_size, hipStream_t stream) {
    static int grid = 0;
    if (grid == 0) {
        if (n_in != 18 || out_size != M * DM || ws_size < WS_END) { fprintf(stderr, "kernel_launch: unexpected sizes n_in %d out %d ws %zu\n", n_in, out_size, ws_size); grid = -1; return; }
        int dev = 0, cus = 0;
        if (hipGetDevice(&dev) != hipSuccess || hipDeviceGetAttribute(&cus, hipDeviceAttributeMultiprocessorCount, dev) != hipSuccess) { grid = -1; return; }
        if (hipFuncSetAttribute((const void*)mk_fwd, hipFuncAttributeMaxDynamicSharedMemorySize, LDS_BYTES) != hipSuccess) { fprintf(stderr, "kernel_launch: hipFuncSetAttribute failed\n"); grid = -1; return; }
        (void)hipGetLastError();
        grid = cus;
    }
    if (grid < 0) return;
    unsigned char* ws = (unsigned char*)d_ws; float* out = (float*)d_out;
    (void)hipMemsetAsync((char*)d_ws + WS_CTL, 0, CTL_ZERO_BYTES, stream);
    Args a{}; for (int i = 0; i < 18; ++i) a.in[i] = (const float*)d_in[i]; a.out = out; a.ws = ws;
    int li = 0;
#define MKF(lo_, hi_, fl_) do { a.ph_lo = (lo_); a.ph_hi = (hi_); a.pad = (fl_); a.li = li++; hipLaunchKernelGGL(mk_fwd, dim3(grid), dim3(NWAVES * 64), LDS_BYTES, stream, a); } while (0)
#define MK(lo_, hi_) MKF(lo_, hi_, 1)
#ifndef PROBE_PHASE
#define PROBE_PHASE -1
#endif
#ifndef PROBE_FLAGS
#define PROBE_FLAGS 1
#endif
    if (PROBE_PHASE < 0) MK(0, 9);
    else { MK(0, PROBE_PHASE + 1); MKF(PROBE_PHASE, PROBE_PHASE + 1, PROBE_FLAGS); if (PROBE_PHASE + 1 < 9) MK(PROBE_PHASE + 1, 9); }
}
```

```cpp
#include <hip/hip_runtime.h>
#include <stdint.h>
#include <stdio.h>

typedef unsigned short bf16_t;
typedef short bf16x8 __attribute__((ext_vector_type(8)));
typedef float f32x4 __attribute__((ext_vector_type(4)));
typedef float f32x2 __attribute__((ext_vector_type(2)));
typedef unsigned u32x4 __attribute__((ext_vector_type(4)));
typedef unsigned u32x2 __attribute__((ext_vector_type(2)));

constexpr int NB = 16, SEQ = 2048, DM = 1024, M = NB * SEQ;
constexpr int PLE = 256, DIN = 6656, DFF = 2816;
constexpr float EPS = 1e-6f;
constexpr float LOG2E = 1.4426950408889634f;
constexpr size_t MiB = 1u << 20;
constexpr size_t WS_CTL = 0, CTL_ZERO_BYTES = 256 * 1024;
constexpr size_t WS_RSTD0 = 1 * MiB, WS_RSTD1 = WS_RSTD0 + 128 * 1024, WS_RSTD2 = WS_RSTD1 + 128 * 1024;
constexpr size_t WS_ROPE = 2 * MiB;
constexpr size_t WS_W1 = 4 * MiB;
constexpr size_t WS_WAB = WS_W1 + (size_t)DIN * DM * 2;
constexpr size_t WS_WO = WS_WAB + (size_t)DM * 1536 * 2;
constexpr size_t WS_W2 = WS_WO + (size_t)DM * DM * 2;
constexpr size_t WS_W3 = WS_W2 + (size_t)2 * DFF * DM * 2;
constexpr size_t WS_WPG = WS_W3 + (size_t)DM * DFF * 2;
constexpr size_t WS_WPP = WS_WPG + (size_t)DM * DM * 2;
constexpr size_t WS_WEND = WS_WPP + (size_t)DM * PLE * 2;
static_assert(WS_WEND <= 44 * MiB, "weights");
constexpr size_t WS_PART1 = 44 * MiB, WS_PART2 = 46 * MiB;
constexpr size_t WS_POOL = 80 * MiB;
constexpr size_t WS_QSB = 48 * MiB, WS_KSB = WS_POOL, WS_VSB = WS_POOL + 4 * MiB, WS_QR = WS_POOL + 8 * MiB, WS_KR = WS_POOL + 12 * MiB, WS_VR = WS_POOL + 16 * MiB,
                 WS_SGR = WS_POOL + 24 * MiB, WS_SA = 336 * MiB, WS_SB = 400 * MiB, WS_PB = 464 * MiB, WS_MISC = 480 * MiB, WS_END = 512 * MiB;
constexpr size_t GSK_4 = (28u << 20) / 2, GSK_8 = (24u << 20) / 2, GSK_ACT = (10u << 20) / 2;
constexpr size_t WS_T1 = 48 * MiB;
constexpr size_t WS_MERGED = WS_SB;
constexpr size_t WS_X1B = WS_POOL;
constexpr size_t WS_ARAW = 112 * MiB;
constexpr size_t WS_ACT = WS_POOL + 8 * MiB;
constexpr size_t WS_PP2 = WS_SB;
constexpr size_t WS_X2B = WS_SA;
constexpr size_t GSKIP_EL = 4u << 20;
constexpr size_t WS_HALO = WS_MISC;
constexpr size_t HALO_ELEMS = (size_t)128 * 2 * DFF;
constexpr size_t WS_W2NAT = 492 * MiB;

__device__ __forceinline__ bf16_t f2bf(float f) { unsigned u = __builtin_bit_cast(unsigned, f); return (bf16_t)((u + 0x7fffu + ((u >> 16) & 1u)) >> 16); }
__device__ __forceinline__ float bf2f(bf16_t b) { return __builtin_bit_cast(float, (unsigned)b << 16); }
__device__ __forceinline__ float sigmoidf_(float x) { return 1.f / (1.f + __expf(-x)); }
__device__ __forceinline__ float gelu_tanh(float x) { const float u = 0.7978845608028654f * (x + 0.044715f * x * x * x); return x * sigmoidf_(2.f * u); }
__device__ __forceinline__ float fast_sigmoid(float x) { return __builtin_amdgcn_rcpf(1.f + __builtin_amdgcn_exp2f(-LOG2E * x)); }
__device__ __forceinline__ float sigmoid_z(float z) { return __builtin_amdgcn_rcpf(1.f + __builtin_amdgcn_exp2f(z)); }
__device__ __forceinline__ float fast_gelu(float x) { const float u = x * (-1.5957691216057308f * LOG2E - 0.0713548162726f * LOG2E * x * x); return x * __builtin_amdgcn_rcpf(1.f + __builtin_amdgcn_exp2f(u)); }
__device__ __forceinline__ unsigned cvt_pk_bf16(float lo, float hi) { unsigned r; asm volatile("v_cvt_pk_bf16_f32 %0, %1, %2" : "=v"(r) : "v"(lo), "v"(hi)); return r; }
__device__ __forceinline__ float rstd_part(const float* part, int row) {
    const f32x4* p = (const f32x4*)(part + (size_t)row * 16); const f32x4 a = p[0], b = p[1], c = p[2], d = p[3];
    const float s = ((a[0] + a[1]) + (a[2] + a[3])) + ((b[0] + b[1]) + (b[2] + b[3])) + ((c[0] + c[1]) + (c[2] + c[3])) + ((d[0] + d[1]) + (d[2] + d[3]));
    return 1.0f / sqrtf(s * (1.f / DM) + EPS);
}

namespace pg8 {
#define PG8_LAS __attribute__((address_space(3)))
typedef unsigned short bf16_t;
typedef short bf16x8 __attribute__((ext_vector_type(8)));
typedef float f32x4 __attribute__((ext_vector_type(4)));
typedef unsigned u32x4 __attribute__((ext_vector_type(4)));
constexpr int BM = 256, BK = 64, HALF = 128, HTB = HALF * BK * 2  , STAGE_BYTES = 8 * HTB, NXCD = 8, WGM = 4;

__host__ __device__ __forceinline__ int lds_byte(int r, int c) { const int st = (r >> 4) * 2 + (c >> 5), rr = r & 15, cc = c & 31, ob = rr * 64 + cc * 2; return st * 1024 + (ob ^ (((ob >> 9) & 1) << 5)); }
__host__ __device__ __forceinline__ void stage_rc(int b, int& R, int& C) { const int st = b / 1024, sb = b % 1024, swz = sb ^ (((sb >> 9) & 1) << 5); R = (st >> 1) * 16 + swz / 64; C = (st & 1) * 32 + (swz % 64) / 2; }
__host__ __device__ __forceinline__ int perm32(int rho) { const int n = rho >> 4, i = rho & 15; return 8 * (i >> 2) + 4 * n + (i & 3); }

struct Unit { int pm, pn, part; };
struct Gemm { const bf16_t* A; const bf16_t* Bt; int M, N, K; int lda; const bf16_t* A2; int lda2, pad2; };

struct StaticOrder {
    int nM, nN, nwg, G, c; int rev = 0;
    __host__ __device__ void init(int M, int N, int G_, int c_) { nM = M / BM; nN = N / BM; nwg = nM * nN; G = G_; c = c_; }
    __host__ __device__ bool next(int i, Unit& u) const {
        const long L = (long)i * G + c; if (L >= nwg) return false;
        int wgid = (int)L; { const int q = nwg / NXCD, r = nwg % NXCD, xcd = wgid % NXCD, off = wgid / NXCD; wgid = (xcd < r ? xcd * (q + 1) : r * (q + 1) + (xcd - r) * q) + off; }
        const int nig = WGM * nN, gid = wgid / nig, fm = gid * WGM, gsz = (nM - fm) < WGM ? (nM - fm) : WGM;
        u.pm = fm + ((wgid % nig) % gsz); u.pn = (wgid % nig) / gsz; u.part = 0; if (rev) u.pm = (u.pm & ~15) + 15 - (u.pm & 15); return true;
    }
    int ntk;
    __device__ __forceinline__ int nt(const Unit&) const { return ntk; }
    __device__ __forceinline__ size_t koff(const Unit&) const { return 0; }
    __device__ __forceinline__ bool a_alt(const Unit&) const { return false; }
    __device__ __forceinline__ void a_ready(const Unit&) const {}
    __device__ __forceinline__ void done(const Unit&) const {}
};


struct CatOrder { StaticOrder a, b; int na, pnoff;
    __device__ __forceinline__ bool next(int i, Unit& u) const { if (i < na) { if (!a.next(i, u)) return false; u.pn += pnoff; return true; } return b.next(i - na, u); }
    __device__ __forceinline__ int nt(const Unit&) const { return a.ntk; }
    __device__ __forceinline__ size_t koff(const Unit&) const { return 0; }
    __device__ __forceinline__ bool a_alt(const Unit&) const { return false; }
    __device__ __forceinline__ void a_ready(const Unit&) const {}
    __device__ __forceinline__ void done(const Unit&) const {}
};

struct PairOrder { StaticOrder base;
    __device__ __forceinline__ bool next(int i, Unit& u) const { if (!base.next(i >> 1, u)) return false; u.part = i & 1; return true; }
    __device__ __forceinline__ int nt(const Unit& u) const { return u.part ? 16 : 8; }
    __device__ __forceinline__ size_t koff(const Unit& u) const { return u.part ? 1024 : 0; }
    __device__ __forceinline__ bool a_alt(const Unit& u) const { return u.part == 0; }
    __device__ __forceinline__ void a_ready(const Unit&) const {}
    __device__ __forceinline__ void done(const Unit&) const {}
};
#define EPI_ARGS f32x4 (&acc)[2][2][4][2], const Unit& u, int wr, int wc, int fr, int fq, PG8_LAS unsigned char* lds, int wid, int lane
struct EpStore { int unused0; int ld; bf16_t* O;
    __device__ __forceinline__ bool keep(const Unit&) const { return false; }
    __device__ __forceinline__ void operator()(EPI_ARGS) const {
        { int l_; asm volatile("v_mbcnt_lo_u32_b32 %0, -1, 0\n\tv_mbcnt_hi_u32_b32 %0, -1, %0" : "=v"(l_)); fr = l_ & 15; fq = l_ >> 4; }
#pragma unroll
        for (int ai = 0; ai < 2; ++ai)
#pragma unroll
            for (int m = 0; m < 4; ++m) { const int row = u.pm * BM + ai * HALF + wr * 64 + m * 16 + fr;
#pragma unroll
                for (int bj = 0; bj < 2; ++bj) { const int col = u.pn * BM + bj * HALF + wc * 32 + 8 * fq; const f32x4 v0 = acc[ai][bj][m][0], v1 = acc[ai][bj][m][1];
                    u32x4 w; w.x = cvt_pk_bf16(v0[0], v0[1]); w.y = cvt_pk_bf16(v0[2], v0[3]); w.z = cvt_pk_bf16(v1[0], v1[1]); w.w = cvt_pk_bf16(v1[2], v1[3]);
                    *(u32x4*)(O + (size_t)row * ld + col) = w; } }
    }
};
template <bool BASE_BF16> struct EpResid { int gskip; int oskip; const void* basev; bf16_t* ob; float* part;
    __device__ __forceinline__ bool keep(const Unit&) const { return false; }
    __device__ __forceinline__ void operator()(EPI_ARGS) const {
        { int l_; asm volatile("v_mbcnt_lo_u32_b32 %0, -1, 0\n\tv_mbcnt_hi_u32_b32 %0, -1, %0" : "=v"(l_)); fr = l_ & 15; fq = l_ >> 4; }
#pragma unroll
        for (int ai = 0; ai < 2; ++ai) {
            f32x4 pf32[BASE_BF16 ? 1 : 4][2][2]; u32x4 pb16[BASE_BF16 ? 4 : 1][2];
#pragma unroll
            for (int m = 0; m < 4; ++m)
#pragma unroll
                for (int bj = 0; bj < 2; ++bj) { const size_t o = (size_t)(u.pm * BM + ai * HALF + wr * 64 + m * 16 + fr) * DM + u.pn * BM + bj * HALF + wc * 32 + 8 * fq;
                    const size_t ob_ = o + (size_t)(u.pm >> 4) * (size_t)gskip;
                    if constexpr (BASE_BF16) pb16[m][bj] = *(const u32x4*)((const bf16_t*)basev + ob_);
                    else { pf32[m][bj][0] = *(const f32x4*)((const float*)basev + ob_); pf32[m][bj][1] = *(const f32x4*)((const float*)basev + ob_ + 4); } }
#pragma unroll
            for (int m = 0; m < 4; ++m) { const int row = u.pm * BM + ai * HALF + wr * 64 + m * 16 + fr; float ss = 0.f;
#pragma unroll
                for (int bj = 0; bj < 2; ++bj) { const size_t o = (size_t)row * DM + u.pn * BM + bj * HALF + wc * 32 + 8 * fq;
                    f32x4 r0, r1;
                    if constexpr (BASE_BF16) { const u32x4 bw = pb16[m][bj];
                        r0 = (f32x4){__builtin_bit_cast(float, bw.x << 16), __builtin_bit_cast(float, bw.x & 0xffff0000u), __builtin_bit_cast(float, bw.y << 16), __builtin_bit_cast(float, bw.y & 0xffff0000u)};
                        r1 = (f32x4){__builtin_bit_cast(float, bw.z << 16), __builtin_bit_cast(float, bw.z & 0xffff0000u), __builtin_bit_cast(float, bw.w << 16), __builtin_bit_cast(float, bw.w & 0xffff0000u)}; }
                    else { r0 = pf32[m][bj][0]; r1 = pf32[m][bj][1]; }
                    r0 = r0 + acc[ai][bj][m][0]; r1 = r1 + acc[ai][bj][m][1];
                    ss += (r0[0] * r0[0] + r0[1] * r0[1]) + (r0[2] * r0[2] + r0[3] * r0[3]) + (r1[0] * r1[0] + r1[1] * r1[1]) + (r1[2] * r1[2] + r1[3] * r1[3]);
                    u32x4 w; w.x = cvt_pk_bf16(r0[0], r0[1]); w.y = cvt_pk_bf16(r0[2], r0[3]); w.z = cvt_pk_bf16(r1[0], r1[1]); w.w = cvt_pk_bf16(r1[2], r1[3]);
                    *(u32x4*)(ob + o + (size_t)(u.pm >> 4) * (size_t)oskip) = w; }
                ss += __shfl_xor(ss, 16); ss += __shfl_xor(ss, 32);
                if (fq == 0) part[(size_t)row * 16 + u.pn * 4 + wc] = ss; }
            asm volatile("" ::: "memory"); }
    }
};
struct EpFinalP { int pm0; int wgm; const float* part; const bf16_t* pp; const bf16_t* x2b; float* out;
    __device__ __forceinline__ bool keep(const Unit&) const { return false; }
    __device__ __forceinline__ void operator()(EPI_ARGS) const {
        { int l_; asm volatile("v_mbcnt_lo_u32_b32 %0, -1, 0\n\tv_mbcnt_hi_u32_b32 %0, -1, %0" : "=v"(l_)); fr = l_ & 15; fq = l_ >> 4; }
#pragma unroll
        for (int ai = 0; ai < 2; ++ai) {
            u32x4 pwv[4][2], xwv[4][2];
#pragma unroll
            for (int m = 0; m < 4; ++m)
#pragma unroll
                for (int bj = 0; bj < 2; ++bj) { const size_t o = (size_t)(u.pm * BM + ai * HALF + wr * 64 + m * 16 + fr) * DM + u.pn * BM + bj * HALF + wc * 32 + 8 * fq; pwv[m][bj] = *(const u32x4*)(pp + o); xwv[m][bj] = *(const u32x4*)(x2b + o); }
#pragma unroll
            for (int m = 0; m < 4; ++m) { const int row = u.pm * BM + ai * HALF + wr * 64 + m * 16 + fr;
                const float rs = ((const PG8_LAS float*)(lds + 131072 + 1024 + 4096))[((u.pm - pm0) / wgm) * 256 + ai * HALF + wr * 64 + m * 16 + fr];
#pragma unroll
                for (int bj = 0; bj < 2; ++bj) { const size_t o = (size_t)row * DM + u.pn * BM + bj * HALF + wc * 32 + 8 * fq;
                    const u32x4 pw = pwv[m][bj], xw = xwv[m][bj];
                    const float rsl = -LOG2E * rs; const f32x4 a0 = acc[ai][bj][m][0] * rsl, a1 = acc[ai][bj][m][1] * rsl; f32x4 r0, r1;
#define LO_(w) __builtin_bit_cast(float, (w) << 16)
#define HI_(w) __builtin_bit_cast(float, (w) & 0xffff0000u)
                    r0[0] = LO_(xw.x) + sigmoid_z(a0[0]) * LO_(pw.x); r0[1] = HI_(xw.x) + sigmoid_z(a0[1]) * HI_(pw.x); r0[2] = LO_(xw.y) + sigmoid_z(a0[2]) * LO_(pw.y); r0[3] = HI_(xw.y) + sigmoid_z(a0[3]) * HI_(pw.y);
                    r1[0] = LO_(xw.z) + sigmoid_z(a1[0]) * LO_(pw.z); r1[1] = HI_(xw.z) + sigmoid_z(a1[1]) * HI_(pw.z); r1[2] = LO_(xw.w) + sigmoid_z(a1[2]) * LO_(pw.w); r1[3] = HI_(xw.w) + sigmoid_z(a1[3]) * HI_(pw.w);
#undef LO_
#undef HI_
                    __builtin_nontemporal_store(r0, (f32x4*)(out + o)); __builtin_nontemporal_store(r1, (f32x4*)(out + o + 4)); } }
            asm volatile("" ::: "memory"); }
    }
};
struct EpMerged { int unused0; int pad; const bf16_t* sA; bf16_t* sB;
    __device__ __forceinline__ bool keep(const Unit& u) const { return u.part == 0; }
    __device__ __forceinline__ void ratio(f32x4 (&acc)[2][2][4][2], const Unit& u, int wr, int wc, int fr, int fq) const {
#pragma unroll
        for (int ai = 0; ai < 2; ++ai) {
            u32x4 rv[4][2];
#pragma unroll
            for (int m = 0; m < 4; ++m)
#pragma unroll
                for (int bj = 0; bj < 2; ++bj) rv[m][bj] = *(const u32x4*)(sA + (size_t)(u.pm * BM + ai * HALF + wr * 64 + m * 16 + fr) * DM + u.pn * BM + bj * HALF + wc * 32 + 8 * fq);
#pragma unroll
            for (int m = 0; m < 4; ++m)
#pragma unroll
                for (int bj = 0; bj < 2; ++bj) { const u32x4 a = rv[m][bj];
                    acc[ai][bj][m][0][0] *= __builtin_bit_cast(float, a.x << 16); acc[ai][bj][m][0][1] *= __builtin_bit_cast(float, a.x & 0xffff0000u); acc[ai][bj][m][0][2] *= __builtin_bit_cast(float, a.y << 16); acc[ai][bj][m][0][3] *= __builtin_bit_cast(float, a.y & 0xffff0000u);
                    acc[ai][bj][m][1][0] *= __builtin_bit_cast(float, a.z << 16); acc[ai][bj][m][1][1] *= __builtin_bit_cast(float, a.z & 0xffff0000u); acc[ai][bj][m][1][2] *= __builtin_bit_cast(float, a.w << 16); acc[ai][bj][m][1][3] *= __builtin_bit_cast(float, a.w & 0xffff0000u); }
            asm volatile("" ::: "memory"); }
    }
    __device__ __forceinline__ void operator()(EPI_ARGS) const {
        { int l_; asm volatile("v_mbcnt_lo_u32_b32 %0, -1, 0\n\tv_mbcnt_hi_u32_b32 %0, -1, %0" : "=v"(l_)); fr = l_ & 15; fq = l_ >> 4; }
        if (u.part == 0) { ratio(acc, u, wr, wc, fr, fq); return; }
#pragma unroll
        for (int ai = 0; ai < 2; ++ai) {
            u32x4 bv[4][2];
#pragma unroll
            for (int m = 0; m < 4; ++m)
#pragma unroll
                for (int bj = 0; bj < 2; ++bj) bv[m][bj] = *(const u32x4*)(sB + (size_t)(u.pm * BM + ai * HALF + wr * 64 + m * 16 + fr) * DM + u.pn * BM + bj * HALF + wc * 32 + 8 * fq);
#pragma unroll
            for (int m = 0; m < 4; ++m) { const int row = u.pm * BM + ai * HALF + wr * 64 + m * 16 + fr;
#pragma unroll
                for (int bj = 0; bj < 2; ++bj) { const size_t o = (size_t)row * DM + u.pn * BM + bj * HALF + wc * 32 + 8 * fq;
                    const u32x4 b = bv[m][bj]; const f32x4 v0 = acc[ai][bj][m][0], v1 = acc[ai][bj][m][1];
#define LO(w) fmaxf(__builtin_bit_cast(float, (w) << 16), 1e-30f)
#define HI(w) fmaxf(__builtin_bit_cast(float, (w) & 0xffff0000u), 1e-30f)
                    u32x4 w; w.x = cvt_pk_bf16(v0[0] * LO(b.x), v0[1] * HI(b.x)); w.y = cvt_pk_bf16(v0[2] * LO(b.y), v0[3] * HI(b.y));
                    w.z = cvt_pk_bf16(v1[0] * LO(b.z), v1[1] * HI(b.z)); w.w = cvt_pk_bf16(v1[2] * LO(b.w), v1[3] * HI(b.w));
#undef LO
#undef HI
                    *(u32x4*)(sB + o) = w; } }
            asm volatile("" ::: "memory"); }
    }
};
struct EpProj { int pn_base; int pad; const float* rstd0; unsigned char* ws; const float* gq; const float* gk; const float* rope;
    __device__ __forceinline__ bool keep(const Unit&) const { return false; }
    __device__ __forceinline__ void operator()(EPI_ARGS) const {
        { int l_; asm volatile("v_mbcnt_lo_u32_b32 %0, -1, 0\n\tv_mbcnt_hi_u32_b32 %0, -1, %0" : "=v"(l_)); fr = l_ & 15; fq = l_ >> 4; }
        const int pn = u.pn + pn_base;
        if (pn < 4) {
            const bool isq = pn < 2; bf16_t* dst = (bf16_t*)(ws + (isq ? WS_QSB : WS_KSB)) + (isq ? (size_t)0 : (size_t)(u.pm >> 4) * GSK_4); const float* gain = isq ? gq : gk; const float scale = isq ? 0.125f * LOG2E : 1.f;
            const int h = 4 * (pn & 1) + wc;
            f32x4 gv[2][2];
#pragma unroll
            for (int bj = 0; bj < 2; ++bj)
#pragma unroll
                for (int n = 0; n < 2; ++n) gv[bj][n] = *(const f32x4*)(gain + h * 64 + 32 * bj + 8 * fq + 4 * n);
#pragma unroll
            for (int ai = 0; ai < 2; ++ai)
#pragma unroll
                for (int m = 0; m < 4; ++m) { const int row = u.pm * BM + ai * HALF + wr * 64 + m * 16 + fr; const float rs = rstd0[row];
                    f32x4 v[2][2]; float ss = 0.f;
#pragma unroll
                    for (int bj = 0; bj < 2; ++bj)
#pragma unroll
                        for (int n = 0; n < 2; ++n) { v[bj][n] = acc[ai][bj][m][n] * rs; ss += (v[bj][n][0] * v[bj][n][0] + v[bj][n][1] * v[bj][n][1]) + (v[bj][n][2] * v[bj][n][2] + v[bj][n][3] * v[bj][n][3]); }
                    ss += __shfl_xor(ss, 16); ss += __shfl_xor(ss, 32);
                    const float r = scale / sqrtf(ss * (1.f / 64.f) + EPS);
#pragma unroll
                    for (int bj = 0; bj < 2; ++bj) { const f32x4 o0 = v[bj][0] * gv[bj][0] * r, o1 = v[bj][1] * gv[bj][1] * r;
                        u32x4 w; w.x = cvt_pk_bf16(o0[0], o0[1]); w.y = cvt_pk_bf16(o0[2], o0[3]); w.z = cvt_pk_bf16(o1[0], o1[1]); w.w = cvt_pk_bf16(o1[2], o1[3]);
                        *(u32x4*)(dst + (size_t)row * 512 + h * 64 + 32 * bj + 8 * fq) = w; } }
        } else if (pn >= 6 && pn < 10) {
            const bool isq = pn < 8; bf16_t* dst = (bf16_t*)(ws + (isq ? WS_QR : WS_KR)) + (size_t)(u.pm >> 4) * GSK_4; const int h = 4 * (pn & 1) + wc;
            const float lg = log2f(1.f - exp2f(-5.f - (float)h));
#pragma unroll
            for (int ai = 0; ai < 2; ++ai)
#pragma unroll
                for (int m = 0; m < 4; ++m) { const int row = u.pm * BM + ai * HALF + wr * 64 + m * 16 + fr; const int t = row & (SEQ - 1); const float ic = (float)(t & 127);
                    const float sc = rstd0[row] * (isq ? exp2f(lg * ic) : 0.125f * exp2f(-lg * ic));
                    u32x4 w1, w2;
#pragma unroll
                    for (int n = 0; n < 2; ++n) { const f32x4 c = *(const f32x4*)(rope + (size_t)t * 32 + 8 * fq + 4 * n), s = *(const f32x4*)(rope + (size_t)SEQ * 32 + (size_t)t * 32 + 8 * fq + 4 * n);
                        const f32x4 x1 = acc[ai][0][m][n], x2 = acc[ai][1][m][n]; const f32x4 o1 = (x1 * c - x2 * s) * sc, o2 = (x1 * s + x2 * c) * sc;
                        if (n == 0) { w1.x = cvt_pk_bf16(o1[0], o1[1]); w1.y = cvt_pk_bf16(o1[2], o1[3]); w2.x = cvt_pk_bf16(o2[0], o2[1]); w2.y = cvt_pk_bf16(o2[2], o2[3]); }
                        else { w1.z = cvt_pk_bf16(o1[0], o1[1]); w1.w = cvt_pk_bf16(o1[2], o1[3]); w2.z = cvt_pk_bf16(o2[0], o2[1]); w2.w = cvt_pk_bf16(o2[2], o2[3]); } }
                    bf16_t* dp = dst + ((size_t)((row >> 11) * 8 + h) * SEQ + t) * 64 + 8 * fq;
                    *(u32x4*)dp = w1; *(u32x4*)(dp + 32) = w2; }
        } else if (pn >= 18) {
            bf16_t* dR = (bf16_t*)(ws + WS_SA); bf16_t* dB = (bf16_t*)(ws + WS_SB); const int c0 = (pn - 18) * 128 + wc * 32 + 8 * fq;
#pragma unroll
            for (int ai = 0; ai < 2; ++ai)
#pragma unroll
                for (int m = 0; m < 4; ++m) { const int row = u.pm * BM + ai * HALF + wr * 64 + m * 16 + fr; const float rsl = -LOG2E * rstd0[row];
                    f32x4 rr[2], sb[2];
#pragma unroll
                    for (int n = 0; n < 2; ++n)
#pragma unroll
                        for (int i = 0; i < 4; ++i) {
                            const float da = 1.f + __builtin_amdgcn_exp2f(acc[ai][0][m][n][i] * rsl), db = 1.f + __builtin_amdgcn_exp2f(fminf(acc[ai][1][m][n][i] * rsl, 100.f));
                            sb[n][i] = __builtin_amdgcn_rcpf(db); rr[n][i] = db * __builtin_amdgcn_rcpf(da); }
                    u32x4 w; w.x = cvt_pk_bf16(rr[0][0], rr[0][1]); w.y = cvt_pk_bf16(rr[0][2], rr[0][3]); w.z = cvt_pk_bf16(rr[1][0], rr[1][1]); w.w = cvt_pk_bf16(rr[1][2], rr[1][3]);
                    __builtin_nontemporal_store(w, (u32x4*)(dR + (size_t)row * DM + c0));
                    u32x4 x; x.x = cvt_pk_bf16(sb[0][0], sb[0][1]); x.y = cvt_pk_bf16(sb[0][2], sb[0][3]); x.z = cvt_pk_bf16(sb[1][0], sb[1][1]); x.w = cvt_pk_bf16(sb[1][2], sb[1][3]);
                    __builtin_nontemporal_store(x, (u32x4*)(dB + (size_t)row * DM + c0)); }
        } else {
            bf16_t* dst; int ld, cbase, actk;
            if (pn < 6) { dst = (bf16_t*)(ws + WS_VSB) + (size_t)(u.pm >> 4) * GSK_4; ld = 512; cbase = (pn - 4) * 256; actk = 0; }
            else if (pn < 14) { dst = (bf16_t*)(ws + WS_VR) + (size_t)(u.pm >> 4) * GSK_8; ld = 1024; cbase = (pn - 10) * 256; actk = 0; }
            else if (pn < 18) { dst = (bf16_t*)(ws + WS_SGR) + (size_t)(u.pm >> 4) * GSK_8; ld = 1024; cbase = (pn - 14) * 256; actk = 1; }
            else if (pn < 22) { dst = (bf16_t*)(ws + WS_SA); ld = 1024; cbase = (pn - 18) * 256; actk = 2; }
            else { dst = (bf16_t*)(ws + WS_SB); ld = 1024; cbase = (pn - 22) * 256; actk = 2; }
#pragma unroll
            for (int ai = 0; ai < 2; ++ai)
#pragma unroll
                for (int m = 0; m < 4; ++m) { const int row = u.pm * BM + ai * HALF + wr * 64 + m * 16 + fr; const float rs = rstd0[row];
#pragma unroll
                    for (int bj = 0; bj < 2; ++bj) { f32x4 v0 = acc[ai][bj][m][0] * rs, v1 = acc[ai][bj][m][1] * rs;
                        if (actk) { const float rsl = -LOG2E * rs; const f32x4 z0 = acc[ai][bj][m][0] * rsl, z1 = acc[ai][bj][m][1] * rsl;
#pragma unroll
                            for (int i = 0; i < 4; ++i) { const float s0 = sigmoid_z(z0[i]), s1 = sigmoid_z(z1[i]); v0[i] = actk == 1 ? v0[i] * s0 : s0; v1[i] = actk == 1 ? v1[i] * s1 : s1; } }
                        u32x4 w; w.x = cvt_pk_bf16(v0[0], v0[1]); w.y = cvt_pk_bf16(v0[2], v0[3]); w.z = cvt_pk_bf16(v1[0], v1[1]); w.w = cvt_pk_bf16(v1[2], v1[3]);
                        if (pn >= 10 && pn < 18) *(u32x4*)(dst + ((size_t)((row >> 11) * 8 + (cbase >> 7) + bj) * SEQ + (row & (SEQ - 1))) * 128 + wc * 32 + 8 * fq) = w;
                        else *(u32x4*)(dst + (size_t)row * ld + cbase + bj * HALF + wc * 32 + 8 * fq) = w; } }
        }
    }
};
__device__ __forceinline__ float dpp_ror1(float v) { return __builtin_bit_cast(float, __builtin_amdgcn_update_dpp(0, __builtin_bit_cast(int, v), 0x121, 0xF, 0xF, false)); }
__device__ __forceinline__ float dpp_ror2(float v) { return __builtin_bit_cast(float, __builtin_amdgcn_update_dpp(0, __builtin_bit_cast(int, v), 0x122, 0xF, 0xF, false)); }
struct EpUp { int pm0; int wgm; const float* part1; const float* cw; const float* cb; bf16_t* act; float* halo;
    __device__ __forceinline__ bool keep(const Unit&) const { return false; }
    __device__ __forceinline__ void operator()(EPI_ARGS) const {
        { int l_; asm volatile("v_mbcnt_lo_u32_b32 %0, -1, 0\n\tv_mbcnt_hi_u32_b32 %0, -1, %0" : "=v"(l_)); fr = l_ & 15; fq = l_ >> 4; }
        const int ch0 = u.pn * 128 + wc * 32 + 8 * fq;
        PG8_LAS float* X = (PG8_LAS float*)(lds + 131072 + 1024);
        f32x4 cw0[2], cw1[2], cw2[2], cbb[2];
#pragma unroll
        for (int n = 0; n < 2; ++n) { cw0[n] = *(const f32x4*)(cw + ch0 + 4 * n); cw1[n] = *(const f32x4*)(cw + DFF + ch0 + 4 * n); cw2[n] = *(const f32x4*)(cw + 2 * DFF + ch0 + 4 * n); cbb[n] = *(const f32x4*)(cb + ch0 + 4 * n); }
        float rsv[2][4];
#pragma unroll
        for (int ai = 0; ai < 2; ++ai)
#pragma unroll
            for (int m = 0; m < 4; ++m) rsv[ai][m] = ((const PG8_LAS float*)(lds + 131072 + 1024 + 4096))[((u.pm - pm0) / wgm) * 256 + ai * HALF + wr * 64 + m * 16 + fr];
        if (fr >= 14) {
#pragma unroll
            for (int ai = 0; ai < 2; ++ai)
#pragma unroll
                for (int n = 0; n < 2; ++n) *(PG8_LAS f32x4*)(X + (((ai * 2 + wr) * 4 + wc) * 2 + (fr - 14)) * 32 + 8 * fq + 4 * n) = acc[ai][0][3][n] * rsv[ai][3];
            if (wr == 1) {
#pragma unroll
                for (int n = 0; n < 2; ++n) *(f32x4*)(halo + ((size_t)u.pm * 2 + (fr - 14)) * DFF + ch0 + 4 * n) = acc[1][0][3][n] * rsv[1][3]; }
        }
        if (fr < 2 && wr == 0) {
#pragma unroll
            for (int n = 0; n < 2; ++n) { *(f32x4*)(halo + HALO_ELEMS + ((size_t)u.pm * 2 + fr) * DFF + ch0 + 4 * n) = acc[0][0][0][n] * rsv[0][0];
                                          *(f32x4*)(halo + 2 * HALO_ELEMS + ((size_t)u.pm * 2 + fr) * DFF + ch0 + 4 * n) = acc[0][1][0][n] * rsv[0][0]; }
        }
        asm volatile("s_waitcnt lgkmcnt(0)" ::: "memory"); __builtin_amdgcn_s_barrier(); asm volatile("" ::: "memory");
        const bool l15 = fr == 15, l14 = fr >= 14;
#pragma unroll
        for (int ai = 0; ai < 2; ++ai) {
            f32x4 pvn[2];
#pragma unroll
            for (int m = 0; m < 4; ++m) { const int row = u.pm * BM + ai * HALF + wr * 64 + m * 16 + fr;
                u32x4 w4;
#pragma unroll
                for (int n = 0; n < 2; ++n) {
                    const f32x4 w0 = cw0[n], w1 = cw1[n], w2 = cw2[n], bb = cbb[n];
                    const f32x4 cur = acc[ai][0][m][n] * rsv[ai][m];
                    f32x4 e1, e2;
                    if (m == 0) {
                        const int sai = wr == 1 ? ai : ai - 1, swr = wr == 1 ? 0 : 1;
                        if (sai >= 0) { const f32x4 q14 = *(const PG8_LAS f32x4*)(X + (((sai * 2 + swr) * 4 + wc) * 2 + 0) * 32 + 8 * fq + 4 * n); e1 = *(const PG8_LAS f32x4*)(X + (((sai * 2 + swr) * 4 + wc) * 2 + 1) * 32 + 8 * fq + 4 * n);
#pragma unroll
                            for (int i = 0; i < 4; ++i) e2[i] = l15 ? e1[i] : q14[i]; }
                        else { e1 = e2 = (f32x4){0.f, 0.f, 0.f, 0.f}; }
                    } else { e1 = pvn[n]; e2 = pvn[n]; }
                    f32x4 t1, t2; f32x4 c = bb + w2 * cur;
#pragma unroll
                    for (int i = 0; i < 4; ++i) { t1[i] = l15 ? e1[i] : cur[i]; t2[i] = l14 ? e2[i] : cur[i]; }
                    asm("s_nop 1\n\t"
                        "v_fmac_f32_dpp %0, %4, %12 row_ror:1 row_mask:0xf bank_mask:0xf\n\tv_fmac_f32_dpp %1, %5, %13 row_ror:1 row_mask:0xf bank_mask:0xf\n\t"
                        "v_fmac_f32_dpp %2, %6, %14 row_ror:1 row_mask:0xf bank_mask:0xf\n\tv_fmac_f32_dpp %3, %7, %15 row_ror:1 row_mask:0xf bank_mask:0xf\n\t"
                        "v_fmac_f32_dpp %0, %8, %16 row_ror:2 row_mask:0xf bank_mask:0xf\n\tv_fmac_f32_dpp %1, %9, %17 row_ror:2 row_mask:0xf bank_mask:0xf\n\t"
                        "v_fmac_f32_dpp %2, %10, %18 row_ror:2 row_mask:0xf bank_mask:0xf\n\tv_fmac_f32_dpp %3, %11, %19 row_ror:2 row_mask:0xf bank_mask:0xf"
                        : "+v"(c[0]), "+v"(c[1]), "+v"(c[2]), "+v"(c[3])
                        : "v"(t1[0]), "v"(t1[1]), "v"(t1[2]), "v"(t1[3]), "v"(t2[0]), "v"(t2[1]), "v"(t2[2]), "v"(t2[3]),
                          "v"(w1[0]), "v"(w1[1]), "v"(w1[2]), "v"(w1[3]), "v"(w0[0]), "v"(w0[1]), "v"(w0[2]), "v"(w0[3]));
                    const f32x4 uu = acc[ai][1][m][n] * rsv[ai][m];
                    const unsigned wx = cvt_pk_bf16(fast_gelu(c[0]) * uu[0], fast_gelu(c[1]) * uu[1]), wy = cvt_pk_bf16(fast_gelu(c[2]) * uu[2], fast_gelu(c[3]) * uu[3]);
                    if (n == 0) { w4.x = wx; w4.y = wy; } else { w4.z = wx; w4.w = wy; }
                    pvn[n] = cur; }
                if (!(ai == 0 && m == 0 && wr == 0 && fr < 2)) *(u32x4*)(act + (size_t)(u.pm >> 4) * GSK_ACT + (size_t)row * DFF + ch0) = w4;
                if (m & 1) asm volatile("" ::: "memory"); }
        }
        asm volatile("s_waitcnt lgkmcnt(0)" ::: "memory"); __builtin_amdgcn_s_barrier(); asm volatile("" ::: "memory");
    }
};

template <class Epi, class Sched, bool ALIGN_EPI = false, bool SP2 = false, bool VARA = false>
__device__ __forceinline__ void gemm_phase(PG8_LAS unsigned char* lds, const Gemm g, const Sched& S, const Epi& E, const int wid) {
    int lane; asm volatile("v_mbcnt_lo_u32_b32 %0, -1, 0\n\tv_mbcnt_hi_u32_b32 %0, -1, %0" : "=v"(lane));
    const int tid = wid * 64 + lane, wr = wid >> 2, wc = wid & 3, fr = lane & 15, fq = lane >> 4;
    const int K = g.K;
    const int lda = g.lda ? g.lda : K, lda2 = VARA ? g.lda2 : 0;
    unsigned voffA[2], voffB[2], voffA2[2];
#pragma unroll
    for (int i = 0; i < 2; ++i) { int R, C; stage_rc(tid * 16 + i * 8192, R, C); const int Rb = (R & ~31) + perm32(R & 31);
        voffA[i] = (unsigned)(R * lda + C) * 2u; voffB[i] = (unsigned)(Rb * K + C) * 2u; voffA2[i] = (unsigned)(R * lda2 + C) * 2u; }
    const size_t kstep = (size_t)(BK * 2);
    const size_t hstep = (size_t)HALF * K * 2;
    const size_t tstep = 2 * hstep;
    const size_t hstepA = (size_t)HALF * lda * 2, hstepA2 = (size_t)HALF * lda2 * 2;
#define PG8_ABASE(u_) ((VARA && S.a_alt(u_)) ? (const char*)g.A2 + (size_t)(u_).pm * 2 * hstepA2 : (const char*)g.A + (size_t)(u_).pm * 2 * hstepA + (size_t)((u_).pm >> 4) * (size_t)g.pad2 * 2 + (VARA ? (size_t)0 : S.koff(u_)))
    const unsigned ldsw = (unsigned)wid * 1024u;
    const int aoff = lds_byte(wr * 64 + fr, fq * 8), boff = lds_byte(wc * 32 + fr, fq * 8);
#define PG8_SA(b, h) (((b) * 2 + (h)) * HTB)
#define PG8_SB(b, h) ((4 + (b) * 2 + (h)) * HTB)
#define PG8_STAGE(bufoff, gbase, voff) do { _Pragma("unroll") for (int _i = 0; _i < 2; ++_i) \
        __builtin_amdgcn_global_load_lds((const unsigned*)((const char*)(gbase) + (voff)[_i]), (PG8_LAS unsigned*)(lds + (bufoff) + ldsw + _i * 8192), 16, 0, 0); } while (0)
#define PG8_LDA(dst, b, h) do { _Pragma("unroll") for (int m = 0; m < 4; ++m) _Pragma("unroll") for (int k = 0; k < 2; ++k) dst[m][k] = *(const PG8_LAS bf16x8*)(lds + PG8_SA(b, h) + aoff + m * 2048 + k * 1024); } while (0)
#define PG8_LDB(dst, b, h) do { _Pragma("unroll") for (int n = 0; n < 2; ++n) _Pragma("unroll") for (int k = 0; k < 2; ++k) dst[n][k] = *(const PG8_LAS bf16x8*)(lds + PG8_SB(b, h) + boff + n * 2048 + k * 1024); } while (0)
#define PG8_MMA(ai, bj, At, Bt) do { __builtin_amdgcn_s_setprio(1); _Pragma("unroll") for (int m = 0; m < 4; ++m) _Pragma("unroll") for (int n = 0; n < 2; ++n) _Pragma("unroll") for (int k = 0; k < 2; ++k) \
        acc[ai][bj][m][n] = __builtin_amdgcn_mfma_f32_16x16x32_bf16(Bt[n][k], At[m][k], acc[ai][bj][m][n], 0, 0, 0); __builtin_amdgcn_s_setprio(0); } while (0)
#define PG8_WAIT_V(n) asm volatile("s_waitcnt vmcnt(" #n ")" ::: "memory")
#define PG8_WAIT_L(n) asm volatile("s_waitcnt lgkmcnt(" #n ")" ::: "memory")
#define PG8_BAR __builtin_amdgcn_s_barrier()
#define PG8_SCHED __builtin_amdgcn_sched_barrier(0)
    Unit cur, nxt; int ui = 0;
    if (!S.next(0, cur)) return;
    f32x4 acc[2][2][4][2];
#pragma unroll
    for (int a = 0; a < 2; ++a)
#pragma unroll
        for (int b = 0; b < 2; ++b)
#pragma unroll
            for (int m = 0; m < 4; ++m)
#pragma unroll
                for (int n = 0; n < 2; ++n) acc[a][b][m][n] = (f32x4){0.f, 0.f, 0.f, 0.f};
    bf16x8 At[4][2], B0[2][2], B1[2][2];
    const char* cA = PG8_ABASE(cur); const char* cB = (const char*)g.Bt + (size_t)cur.pn * tstep + S.koff(cur);
    S.a_ready(cur);
    if constexpr (SP2) {
        const bool alt0 = VARA && S.a_alt(cur); const unsigned vA0[2] = {alt0 ? voffA2[0] : voffA[0], alt0 ? voffA2[1] : voffA[1]}; const size_t hA0 = alt0 ? hstepA2 : hstepA;
        PG8_STAGE(PG8_SB(0, 0), cB, voffB); PG8_STAGE(PG8_SB(0, 1), cB + hstep, voffB); PG8_STAGE(PG8_SA(0, 0), cA, vA0); PG8_STAGE(PG8_SA(0, 1), cA + hA0, vA0);
        if (wr == 1) PG8_BAR;
        PG8_WAIT_V(2); PG8_BAR;
        PG8_STAGE(PG8_SB(1, 0), cB + kstep, voffB); PG8_STAGE(PG8_SA(1, 0), cA + kstep, vA0); PG8_STAGE(PG8_SB(1, 1), cB + hstep + kstep, voffB);
        PG8_WAIT_V(6); PG8_BAR;
    } else {
        PG8_STAGE(PG8_SB(0, 0), cB, voffB); PG8_STAGE(PG8_SA(0, 0), cA, voffA); PG8_STAGE(PG8_SB(0, 1), cB + hstep, voffB); PG8_STAGE(PG8_SA(0, 1), cA + hstep, voffA);
        if (wr == 1) PG8_BAR;
        PG8_WAIT_V(4); PG8_BAR;
        PG8_STAGE(PG8_SB(1, 0), cB + kstep, voffB); PG8_STAGE(PG8_SA(1, 0), cA + kstep, voffA); PG8_STAGE(PG8_SB(1, 1), cB + hstep + kstep, voffB);
        PG8_WAIT_V(6); PG8_BAR;
    }
    for (;;) {
        const bool has_next = S.next(ui + 1, nxt);
        const int nt = S.nt(cur);
        const char* nA = has_next ? PG8_ABASE(nxt) : cA; const char* nB = has_next ? (const char*)g.Bt + (size_t)nxt.pn * tstep + S.koff(nxt) : cB;
        for (int t = 0; t < nt; t += 2) {
            const bool last = (t == nt - 2);
            const char* a1 = cA + (size_t)(t + 1) * kstep;
            const char* a2 = last ? nA : cA + (size_t)(t + 2) * kstep; const char* b2 = last ? nB : cB + (size_t)(t + 2) * kstep;
            const char* a3 = a2 + kstep; const char* b3 = b2 + kstep;
            if (last && has_next) S.a_ready(nxt);
            const bool altc = VARA && S.a_alt(cur), alt2 = VARA && ((last && has_next) ? S.a_alt(nxt) : S.a_alt(cur));
            const unsigned vAc[2] = {altc ? voffA2[0] : voffA[0], altc ? voffA2[1] : voffA[1]}, vA2[2] = {alt2 ? voffA2[0] : voffA[0], alt2 ? voffA2[1] : voffA[1]};
            const size_t hAc = altc ? hstepA2 : hstepA, hA2 = alt2 ? hstepA2 : hstepA;
            if constexpr (SP2) {
            PG8_LDB(B0, 0, 0); PG8_LDB(B1, 0, 1); PG8_SCHED; PG8_LDA(At, 0, 0); PG8_STAGE(PG8_SA(1, 1), a1 + hAc, vAc);
            PG8_WAIT_V(8); PG8_WAIT_L(0); PG8_BAR; PG8_MMA(0, 0, At, B0); PG8_MMA(0, 1, At, B1); PG8_BAR; PG8_SCHED;
            PG8_LDA(At, 0, 1); PG8_STAGE(PG8_SB(0, 0), b2, voffB); PG8_STAGE(PG8_SB(0, 1), b2 + hstep, voffB); PG8_STAGE(PG8_SA(0, 0), a2, vA2);
            PG8_WAIT_V(8); PG8_WAIT_L(0); PG8_BAR; PG8_MMA(1, 0, At, B0); PG8_MMA(1, 1, At, B1); PG8_BAR; PG8_SCHED;
            PG8_LDB(B0, 1, 0); PG8_LDB(B1, 1, 1); PG8_SCHED; PG8_LDA(At, 1, 0); PG8_STAGE(PG8_SA(0, 1), a2 + hA2, vA2);
            PG8_WAIT_V(8); PG8_WAIT_L(0); PG8_BAR; PG8_MMA(0, 0, At, B0); PG8_MMA(0, 1, At, B1); PG8_BAR; PG8_SCHED;
            PG8_LDA(At, 1, 1); PG8_STAGE(PG8_SB(1, 0), b3, voffB); PG8_STAGE(PG8_SB(1, 1), b3 + hstep, voffB); PG8_STAGE(PG8_SA(1, 0), a3, vA2);
            PG8_WAIT_V(8); PG8_WAIT_L(0); PG8_BAR; PG8_MMA(1, 0, At, B0); PG8_MMA(1, 1, At, B1); PG8_BAR; PG8_SCHED;
            } else {
            PG8_LDB(B0, 0, 0); PG8_SCHED; PG8_LDA(At, 0, 0); PG8_STAGE(PG8_SA(1, 1), a1 + hstep, voffA);
            PG8_WAIT_L(8); PG8_BAR; PG8_WAIT_L(0); PG8_MMA(0, 0, At, B0); PG8_BAR; PG8_SCHED;
            PG8_LDB(B1, 0, 1); PG8_STAGE(PG8_SB(0, 0), b2, voffB);
            PG8_BAR; PG8_WAIT_L(0); PG8_MMA(0, 1, At, B1); PG8_BAR;
            PG8_LDA(At, 0, 1); PG8_STAGE(PG8_SA(0, 0), a2, voffA);
            PG8_BAR; PG8_WAIT_L(0); PG8_MMA(1, 0, At, B0); PG8_BAR; PG8_SCHED;
            PG8_STAGE(PG8_SB(0, 1), b2 + hstep, voffB);
            PG8_WAIT_V(6); PG8_BAR; PG8_MMA(1, 1, At, B1); PG8_BAR;
            PG8_LDB(B0, 1, 0); PG8_SCHED; PG8_LDA(At, 1, 0); PG8_STAGE(PG8_SA(0, 1), a2 + hstep, voffA);
            PG8_WAIT_L(8); PG8_BAR; PG8_WAIT_L(0); PG8_MMA(0, 0, At, B0); PG8_BAR; PG8_SCHED;
            PG8_LDB(B1, 1, 1); PG8_STAGE(PG8_SB(1, 0), b3, voffB);
            PG8_BAR; PG8_WAIT_L(0); PG8_MMA(0, 1, At, B1); PG8_BAR;
            PG8_LDA(At, 1, 1); PG8_STAGE(PG8_SA(1, 0), a3, voffA);
            PG8_BAR; PG8_WAIT_L(0); PG8_MMA(1, 0, At, B0); PG8_BAR; PG8_SCHED;
            PG8_STAGE(PG8_SB(1, 1), b3 + hstep, voffB);
            PG8_WAIT_V(6); PG8_BAR; PG8_MMA(1, 1, At, B1); PG8_BAR;
            }
        }
        if constexpr (ALIGN_EPI) { if (wr == 0) PG8_BAR; }
        E(acc, cur, wr, wc, fr, fq, lds, wid, lane); S.done(cur);
        if (!has_next) break;
        if (!E.keep(cur))
#pragma unroll
        for (int a = 0; a < 2; ++a)
#pragma unroll
            for (int b = 0; b < 2; ++b)
#pragma unroll
                for (int m = 0; m < 4; ++m)
#pragma unroll
                    for (int n = 0; n < 2; ++n) acc[a][b][m][n] = (f32x4){0.f, 0.f, 0.f, 0.f};
        cur = nxt; cA = nA; cB = nB; ++ui;
        if constexpr (ALIGN_EPI) { if (wr == 1) PG8_BAR; }
    }
    PG8_WAIT_V(0);
    if constexpr (!ALIGN_EPI) { if (wr == 0) PG8_BAR; }
    PG8_BAR;
#undef PG8_ABASE
#undef PG8_SA
#undef PG8_SB
#undef PG8_STAGE
#undef PG8_LDA
#undef PG8_LDB
#undef PG8_MMA
#undef PG8_WAIT_V
#undef PG8_WAIT_L
#undef PG8_BAR
#undef PG8_SCHED
}
}

#define GAS __attribute__((address_space(1)))
#define LAS __attribute__((address_space(3)))
typedef GAS unsigned gu32;
typedef GAS unsigned long long gu64;
#define RLX_AGENT __ATOMIC_RELAXED, __HIP_MEMORY_SCOPE_AGENT
#define LDS_WAIT() asm volatile("s_waitcnt lgkmcnt(0)" ::: "memory")
#define VM_WAIT() asm volatile("s_waitcnt vmcnt(0)" ::: "memory")

#define XB_TMO      128
#define XB_XCNT(j)  (256  + 64 * (j))
#define XB_XSUB(j)  (1280 + 64 * (j))
#define XB_XGEN(j)  (2304 + 64 * (j))
#define XB_TOP      3328
#define XB_TOPGEN   3392
#define XB_XRANK(j) (3456 + 64 * (j))
#define XCD_BAR_WORDS 4480
#define XB_SPIN_CAP (1u << 18)

__device__ __forceinline__ unsigned xb_ld(unsigned* p)              { return __hip_atomic_load(p, __ATOMIC_RELAXED, __HIP_MEMORY_SCOPE_AGENT); }
__device__ __forceinline__ unsigned xb_add(unsigned* p, unsigned v) { return __hip_atomic_fetch_add(p, v, __ATOMIC_RELAXED, __HIP_MEMORY_SCOPE_AGENT); }
__device__ __forceinline__ unsigned xb_xcc_id() { return (unsigned)__builtin_amdgcn_s_getreg((3 << 11) | 20) & 0xFu; }
#define XB_SPIN(cond, bar) do { unsigned _sp = 0; while (cond) { __builtin_amdgcn_s_sleep(1); \
    if ((++_sp & 255u) == 0u) { if (xb_ld(&(bar)[XB_TMO])) break; if (_sp > XB_SPIN_CAP) { atomicAdd(&(bar)[XB_TMO], 1u); break; } } } } while (0)

struct XcdBarrier {
    unsigned* bar; unsigned x;
    volatile LAS unsigned* st;
};

__device__ __forceinline__ XcdBarrier xcd_barrier_post(unsigned* bar, volatile LAS unsigned* st, bool leader) {
    XcdBarrier b; b.bar = bar; b.x = xb_xcc_id(); b.st = st;
    if (leader) { (void)xb_add(&bar[XB_XCNT(b.x)], 1u); st[3] = xb_add(&bar[XB_XRANK(b.x)], 1u); }
    return b;
}
__device__ __forceinline__ void xcd_barrier_complete(unsigned* bar, unsigned x, unsigned& nloc, unsigned& nx, unsigned& regular) {
    const unsigned G = gridDim.x * gridDim.y * gridDim.z;
    unsigned sum, cnt, mine, sp = 0u;
    for (;;) {
        sum = 0u; cnt = 0u; mine = 0u; regular = 1u;
#pragma unroll
        for (unsigned j = 0; j < 16; ++j) { const unsigned c = xb_ld(&bar[XB_XCNT(j)]); sum += c; cnt += (c > 0u) ? 1u : 0u; mine = (j == x) ? c : mine; if (j < 8u ? c != 32u : c != 0u) regular = 0u; }
        if (sum == G) break;
        __builtin_amdgcn_s_sleep(1);
        if ((++sp & 255u) == 0u) { if (xb_ld(&bar[XB_TMO])) break; if (sp > XB_SPIN_CAP) { atomicAdd(&bar[XB_TMO], 1u); break; } }
    }
    nloc = mine > 0u ? mine : 1u; nx = cnt > 0u ? cnt : 1u; if (sum != G || G != 256u) regular = 0u;
}

__device__ __forceinline__ void xcd_barrier(const XcdBarrier& b, int wave_, bool local_only = false) {
    int lane_; asm volatile("v_mbcnt_lo_u32_b32 %0, -1, 0\n\tv_mbcnt_hi_u32_b32 %0, -1, %0" : "=v"(lane_));
    asm volatile("s_waitcnt vmcnt(0)" ::: "memory");
    __syncthreads();
    if (wave_ == 0 && lane_ == 0) {
        unsigned* bar = b.bar;
        __builtin_amdgcn_s_waitcnt(0);
        unsigned nloc = b.st[0], nx = b.st[1];
        if (nloc == 0u) { unsigned reg_; xcd_barrier_complete(bar, b.x, nloc, nx, reg_); b.st[0] = nloc; b.st[1] = nx; b.st[2] = reg_; }
        const unsigned old = xb_add(&bar[XB_XSUB(b.x)], 1u);
        const unsigned gen = old / nloc;
        if (old + 1u == (gen + 1u) * nloc) {
            if (!local_only)
            __builtin_amdgcn_fence(__ATOMIC_RELEASE, "agent");
            asm volatile("s_waitcnt vmcnt(0)" ::: "memory");
            if (!local_only) {
            const unsigned og = xb_add(&bar[XB_TOP], 1u);
            const unsigned tg = og / nx;
            if (og + 1u == (tg + 1u) * nx) xb_add(&bar[XB_TOPGEN], 1u);
            else XB_SPIN(xb_ld(&bar[XB_TOPGEN]) == tg, bar);
            }
            __builtin_amdgcn_fence(__ATOMIC_ACQUIRE, "agent");
            xb_add(&bar[XB_XGEN(b.x)], 1u);
            asm volatile("s_waitcnt vmcnt(0)" ::: "memory");
        } else {
            XB_SPIN(xb_ld(&bar[XB_XGEN(b.x)]) == gen, bar);
            __builtin_amdgcn_fence(__ATOMIC_ACQUIRE, "agent");
            asm volatile("s_waitcnt vmcnt(0)" ::: "memory");
        }
    }
    __syncthreads();
}

__host__ __device__ inline int w1_src_col(int n) { const int pn = n >> 8; if (pn >= 18) { const int sg_ = n & 255; return 4608 + ((sg_ >> 7) ? 1024 : 0) + 128 * (pn - 18) + (sg_ & 127); }
    const bool head = (pn < 4) || (pn >= 6 && pn < 10); if (!head) return n; const int s = n & 255, bj = s >> 7, wc = (s >> 5) & 3, rho = s & 31; return (pn << 8) + 64 * wc + 32 * bj + rho; }
__host__ __device__ inline int w2_src_col(int n) { const int pn = n >> 8, s = n & 255, bj = s >> 7, j = s & 127; return (bj ? DFF : 0) + 128 * pn + j; }
__device__ __forceinline__ float wave_sum(float v) {
#pragma unroll
    for (int o = 1; o < 64; o <<= 1) v += __shfl_xor(v, o);
    return v;
}
__device__ __forceinline__ unsigned pk2(float lo, float hi) { return (unsigned)f2bf(lo) | ((unsigned)f2bf(hi) << 16); }
__device__ __forceinline__ unsigned p0_swap1(unsigned v) { return (unsigned)__builtin_amdgcn_update_dpp(0, (int)v, 0xB1, 0xF, 0xF, false); }
__device__ __forceinline__ void p0_transpose_item(const float* W, const float* gain, int K, int N, bf16_t* WT, int ldw, int mode, LAS float* scr, int item, int lane) {
    const int nblk = N / 32, kb = item / nblk, nb = item % nblk, k0 = 64 * kb, n0 = 32 * nb;
    const int s0 = mode == 1 ? w1_src_col(n0) : mode == 2 ? w2_src_col(n0) : n0;
    f32x4 wv[8];
#pragma unroll
    for (int i = 0; i < 8; ++i) { const int kk = 8 * i + (lane >> 3); wv[i] = __builtin_nontemporal_load((const f32x4*)(W + (size_t)(k0 + kk) * N + s0 + 4 * (lane & 7))); }
#pragma unroll
    for (int i = 0; i < 8; ++i) { const int kk = 8 * i + (lane >> 3); const float gk = gain ? gain[k0 + kk] : 1.f; LAS float* d = scr + kk * 33 + 4 * (lane & 7);
        d[0] = wv[i][0] * gk; d[1] = wv[i][1] * gk; d[2] = wv[i][2] * gk; d[3] = wv[i][3] * gk; }
    LDS_WAIT(); asm volatile("" ::: "memory");
    const int c = lane & 7;
#pragma unroll
    for (int j = 0; j < 4; ++j) { const int n = (lane >> 3) + 8 * j; const LAS float* sp = scr + (8 * c) * 33 + n;
        u32x4 o; o.x = pk2(sp[0 * 33], sp[1 * 33]); o.y = pk2(sp[2 * 33], sp[3 * 33]); o.z = pk2(sp[4 * 33], sp[5 * 33]); o.w = pk2(sp[6 * 33], sp[7 * 33]);
        *(u32x4*)(WT + (size_t)(n0 + n) * ldw + k0 + 8 * c) = o; }
    LDS_WAIT(); asm volatile("" ::: "memory");
}
namespace sba {
typedef float f32x16 __attribute__((ext_vector_type(16)));
typedef short s16x4 __attribute__((ext_vector_type(4)));
typedef short v4i16_t __attribute__((ext_vector_type(4)));
constexpr int VREG = 4096;
constexpr int WAVE_LDS = 4 * VREG;
__device__ __forceinline__ int crow(int r, int hi) { return (r & 3) + 8 * (r >> 2) + 4 * hi; }
__device__ __forceinline__ s16x4 vtr(const LAS unsigned char* p) { return __builtin_bit_cast(s16x4, __builtin_amdgcn_ds_read_tr16_b64_v4i16((LAS v4i16_t*)p)); }

template <bool B> struct BoolC { static constexpr bool value = B; };
__device__ __forceinline__ float smul_(float a, float b) { float r; asm volatile("v_mul_f32 %0, %1, %2" : "=v"(r) : "v"(a), "v"(b)); return r; }
#define SMUL(a_, b_) smul_((a_), (b_))
__device__ __forceinline__ void attn_item(int item, const bf16_t* Q, const bf16_t* Kk, const bf16_t* V, bf16_t* Y, LAS unsigned char* vl, int lane) {
    const int r32 = lane & 31, hi = lane >> 5;
    const int qb = item & 63, h = (item >> 6) & 7, b = item >> 9;
    Kk += (size_t)(b >> 1) * GSK_4; V += (size_t)(b >> 1) * GSK_4;
    const int t0 = qb * 32; const size_t rowbase = (size_t)b * SEQ;
    bf16x8 qf[4];
#pragma unroll
    for (int d0 = 0; d0 < 4; ++d0) qf[d0] = *(const bf16x8*)(Q + (rowbase + t0 + r32) * 512 + h * 64 + d0 * 16 + hi * 8);
    f32x16 o0 = {}, o1 = {};
    float carry = 1.f;
    const int jt = t0 >> 6;
    const int vbase = (4 * hi + ((lane & 15) >> 2)) * 64 + (16 * ((lane >> 4) & 1) + 4 * (lane & 3)) * 2;
    bf16x8 kfA[2][4], kfB[2][4];
#define SBA_LOAD(j_, ib_, kf_) do { const bf16_t* kp_ = Kk + (rowbase + 64 * (j_) + r32) * 512 + h * 64 + hi * 8; const bf16_t* vp_ = V + (rowbase + 64 * (j_) + (lane >> 2)) * 512 + h * 64 + (lane & 3) * 8; \
        _Pragma("unroll") for (int mb_ = 0; mb_ < 2; ++mb_) _Pragma("unroll") for (int d0_ = 0; d0_ < 4; ++d0_) kf_[mb_][d0_] = *(const bf16x8*)(kp_ + (size_t)mb_ * 32 * 512 + d0_ * 16); \
        _Pragma("unroll") for (int mb_ = 0; mb_ < 2; ++mb_) _Pragma("unroll") for (int g_ = 0; g_ < 4; ++g_) \
            __builtin_amdgcn_global_load_lds((const unsigned*)(vp_ + (size_t)g_ * 16 * 512 + mb_ * 32), (LAS unsigned*)(vl + (ib_) * 2 * VREG + mb_ * VREG + g_ * 1024), 16, 0, 0); } while (0)
    int ib = 0;
    SBA_LOAD(jt, 0, kfA);
    auto tile = [&](auto diag_, const int j, bf16x8 (&kf)[2][4], bf16x8 (&kn)[2][4]) -> bool {
        constexpr bool diag = decltype(diag_)::value;
        asm volatile("s_waitcnt vmcnt(0)" ::: "memory");
        f32x16 p0, p1;
        asm("v_mfma_f32_32x32x16_bf16 %0, %1, %2, 0" : "=&v"(p0) : "v"(kf[0][0]), "v"(qf[0]));
        asm("v_mfma_f32_32x32x16_bf16 %0, %1, %2, 0" : "=&v"(p1) : "v"(kf[1][0]), "v"(qf[0]));
#pragma unroll
        for (int d0 = 1; d0 < 4; ++d0) { p0 = __builtin_amdgcn_mfma_f32_32x32x16_bf16(kf[0][d0], qf[d0], p0, 0, 0, 0); p1 = __builtin_amdgcn_mfma_f32_32x32x16_bf16(kf[1][d0], qf[d0], p1, 0, 0, 0); }
        const LAS unsigned char* vcur = vl + ib * 2 * VREG;
        if (j > 0) { SBA_LOAD(j - 1, ib ^ 1, kn); }
        const int qrel = t0 + r32 - 64 * j;
#define PSEL(g_, i_) ((g_) < 4 ? p0[4 * (g_) + (i_)] : p1[4 * ((g_) - 4) + (i_)])
#pragma unroll
        for (int g = 0; g < 8; ++g) {
#pragma unroll
            for (int i = 0; i < 4; ++i) { const int r = 4 * (g & 3) + i; const float sv = g < 4 ? p0[r] : p1[r];
                float e = __builtin_amdgcn_exp2f(sv);
                if (diag) { if (crow(r, hi) + (g < 4 ? 0 : 32) >= qrel) e = 0.f; }
                const float om = __builtin_amdgcn_rcpf(1.f + e);
                if (g < 4) p0[r] = om; else p1[r] = om; } }
        float T[8], ta[8], tb[8];
#pragma unroll
        for (int g = 0; g < 8; ++g) { ta[g] = SMUL(PSEL(g, 0), PSEL(g, 1)); tb[g] = SMUL(PSEL(g, 2), PSEL(g, 3)); }
#pragma unroll
        for (int g = 0; g < 8; ++g) T[g] = SMUL(ta[g], tb[g]);
        float thi_[8], tt[8];
#pragma unroll
        for (int g = 0; g < 8; ++g) { auto rr = __builtin_amdgcn_permlane32_swap(__float_as_uint(T[g]), __float_as_uint(T[g]), false, false);
            thi_[g] = __uint_as_float(rr[1]); tt[g] = SMUL(__uint_as_float(rr[0]), thi_[g]); }
        float base[8]; float R = carry;
#pragma unroll
        for (int g = 7; g >= 0; --g) { const float Rn = SMUL(R, tt[g]); const float rt = SMUL(R, thi_[g]); base[g] = hi ? R : rt; R = Rn; }
        carry = R;
        {   float tq[8], tn[8];
#pragma unroll
            for (int g = 0; g < 8; ++g) tq[g] = base[g];
#pragma unroll
            for (int i = 3; i >= 0; --i) {
#pragma unroll
                for (int g = 0; g < 8; ++g) tn[g] = SMUL(tq[g], PSEL(g, i));
#pragma unroll
                for (int g = 0; g < 8; ++g) { if (g < 4) p0[4 * g + i] = tq[g] - tn[g]; else p1[4 * (g - 4) + i] = tq[g] - tn[g]; tq[g] = tn[g]; } }
        }
#undef PSEL
        bf16x8 pf[4];
#pragma unroll
        for (int s = 0; s < 4; ++s) { u32x4 w;
            if (s < 2) { w.x = cvt_pk_bf16(p0[8 * s], p0[8 * s + 1]); w.y = cvt_pk_bf16(p0[8 * s + 2], p0[8 * s + 3]); w.z = cvt_pk_bf16(p0[8 * s + 4], p0[8 * s + 5]); w.w = cvt_pk_bf16(p0[8 * s + 6], p0[8 * s + 7]); }
            else { const int q = 8 * (s - 2); w.x = cvt_pk_bf16(p1[q], p1[q + 1]); w.y = cvt_pk_bf16(p1[q + 2], p1[q + 3]); w.z = cvt_pk_bf16(p1[q + 4], p1[q + 5]); w.w = cvt_pk_bf16(p1[q + 6], p1[q + 7]); }
            pf[s] = __builtin_bit_cast(bf16x8, w); }
#pragma unroll
        for (int s = 0; s < 4; ++s) {
            const s16x4 a0l = vtr(vcur + vbase + (16 * s) * 64), a0h = vtr(vcur + vbase + (16 * s + 8) * 64);
            const s16x4 a1l = vtr(vcur + VREG + vbase + (16 * s) * 64), a1h = vtr(vcur + VREG + vbase + (16 * s + 8) * 64);
            const bf16x8 A0 = (bf16x8){a0l[0], a0l[1], a0l[2], a0l[3], a0h[0], a0h[1], a0h[2], a0h[3]}, A1 = (bf16x8){a1l[0], a1l[1], a1l[2], a1l[3], a1h[0], a1h[1], a1h[2], a1h[3]};
            o0 = __builtin_amdgcn_mfma_f32_32x32x16_bf16(A0, pf[s], o0, 0, 0, 0); o1 = __builtin_amdgcn_mfma_f32_32x32x16_bf16(A1, pf[s], o1, 0, 0, 0);
        }
        ib ^= 1;
        return __all(carry < 7.8886e-31f);
    };
    if (!tile(BoolC<true>{}, jt, kfA, kfB))
        for (int j = jt - 1; j >= 0; j -= 2) { if (tile(BoolC<false>{}, j, kfB, kfA) || j == 0) break; if (tile(BoolC<false>{}, j - 1, kfA, kfB)) break; }
#undef SBA_LOAD
    bf16_t* yp = Y + (rowbase + t0 + r32) * 512 + h * 64;
    u32x2 wq[2][4];
#pragma unroll
    for (int g = 0; g < 4; ++g) { wq[0][g].x = cvt_pk_bf16(o0[4 * g], o0[4 * g + 1]); wq[0][g].y = cvt_pk_bf16(o0[4 * g + 2], o0[4 * g + 3]);
                                  wq[1][g].x = cvt_pk_bf16(o1[4 * g], o1[4 * g + 1]); wq[1][g].y = cvt_pk_bf16(o1[4 * g + 2], o1[4 * g + 3]); }
#pragma unroll
    for (int mb = 0; mb < 2; ++mb)
#pragma unroll
        for (int gp = 0; gp < 2; ++gp) { const u32x2 a = wq[mb][gp], b = wq[mb][2 + gp];
            const auto sx = __builtin_amdgcn_permlane32_swap(a.x, b.x, false, false), sy = __builtin_amdgcn_permlane32_swap(a.y, b.y, false, false);
            u32x4 st; if (hi) { st.x = sx[0]; st.y = sy[0]; st.z = b.x; st.w = b.y; } else { st.x = a.x; st.y = a.y; st.z = sx[1]; st.w = sy[1]; }
            *(u32x4*)(yp + 32 * mb + 8 * (2 * hi + gp)) = st; }
}
}

namespace ret {
typedef float f32x16 __attribute__((ext_vector_type(16)));
typedef short s16x4 __attribute__((ext_vector_type(4)));
typedef short v4i16_t __attribute__((ext_vector_type(4)));
constexpr int RSTR = 4096 + 32;
constexpr int KT_BYTES = 16640, VT_BYTES = 33280, SB_PITCH = 144, SB_BYTES = 128 * SB_PITCH;
constexpr int OFF_KT = 0, OFF_VT = 2 * KT_BYTES, OFF_SB = OFF_VT + 2 * VT_BYTES, OFF_G = OFF_SB + SB_BYTES, OFF_X = OFF_G + 512, LDS_TOTAL = OFF_X + 1024;
constexpr int OFF_Q = 132096, Q_BYTES = 128 * SB_PITCH;
__device__ __forceinline__ int crow(int r, int hi) { return (r & 3) + 8 * (r >> 2) + 4 * hi; }
__device__ __forceinline__ s16x4 vtr(const LAS unsigned char* p) { return __builtin_bit_cast(s16x4, __builtin_amdgcn_ds_read_tr16_b64_v4i16((LAS v4i16_t*)p)); }
#define RET_BAR() do { asm volatile("s_waitcnt lgkmcnt(0)" ::: "memory"); __builtin_amdgcn_s_barrier(); asm volatile("" ::: "memory"); } while (0)
#define RET_PK(lo_, hi_) ((bf16x8){lo_[0], lo_[1], lo_[2], lo_[3], hi_[0], hi_[1], hi_[2], hi_[3]})

__device__ __forceinline__ void ret_seq(int bh, const bf16_t* Qr, const bf16_t* Kr, const bf16_t* Vr, const bf16_t* SG, const float* gain, bf16_t* Y, LAS unsigned char* L, int tid) {
    const int lane = tid & 63, w = __builtin_amdgcn_readfirstlane(tid >> 6), r32 = lane & 31, hi = lane >> 5, g16 = (lane >> 4) & 1, i16 = lane & 15;
    const int rb = w < 4 ? (w >> 1) : 3 - ((w >> 1) & 1), eh = w & 1;
    const int b = bh >> 3, h = bh & 7; const size_t rowbase = (size_t)b * SEQ, hmbase = (size_t)bh * SEQ;
    const float gmm = 1.f - exp2f(-5.f - (float)h), lg = log2f(gmm); const float gC = exp2f(lg * 128.f), gC1 = exp2f(lg * 127.f);
    f32x16 S = {};
    u32x4 kreg[2], vreg[4], qreg[2];
#define RET_LOAD(n_) do { const size_t r0_ = hmbase + (size_t)(n_) * 128;     \
        _Pragma("unroll") for (int i_ = 0; i_ < 2; ++i_) { const int c_ = tid + 512 * i_; kreg[i_] = *(const u32x4*)(Kr + (r0_ + (c_ >> 3)) * 64 + (c_ & 7) * 8); qreg[i_] = *(const u32x4*)(Qr + (r0_ + (c_ >> 3)) * 64 + (c_ & 7) * 8); } \
        _Pragma("unroll") for (int i_ = 0; i_ < 4; ++i_) { const int c_ = tid + 512 * i_; vreg[i_] = *(const u32x4*)(Vr + (r0_ + (c_ >> 4)) * 128 + (c_ & 15) * 8); } } while (0)
#define RET_WRITE(buf_) do { \
        _Pragma("unroll") for (int i_ = 0; i_ < 2; ++i_) { const int c_ = tid + 512 * i_, key_ = c_ >> 3, part_ = c_ & 7; *(LAS u32x4*)(L + OFF_KT + (buf_) * KT_BYTES + (part_ >> 1) * RSTR + key_ * 32 + (part_ & 1) * 16) = kreg[i_]; \
            *(LAS u32x4*)(L + OFF_Q + key_ * SB_PITCH + part_ * 16) = qreg[i_]; } \
        _Pragma("unroll") for (int i_ = 0; i_ < 4; ++i_) { const int c_ = tid + 512 * i_, key_ = c_ >> 4, part_ = c_ & 15; *(LAS u32x4*)(L + OFF_VT + (buf_) * VT_BYTES + (part_ >> 1) * RSTR + key_ * 32 + (part_ & 1) * 16) = vreg[i_]; } } while (0)
    RET_LOAD(0);
    for (int i = tid; i < SB_BYTES / 4; i += 512) ((LAS unsigned*)(L + OFF_SB))[i] = 0u;
    if (tid < 128) ((LAS float*)(L + OFF_G))[tid] = gain[h * 128 + tid];
    RET_WRITE(0);
    const int troff = (4 * hi + (i16 >> 2)) * 32 + (i16 & 3) * 8;
    const size_t qrow0 = rowbase + 32 * rb + r32;
    RET_BAR();
    for (int n = 0; n < 16; ++n) {
        const int buf = n & 1; const LAS unsigned char* Kt = L + OFF_KT + buf * KT_BYTES; const LAS unsigned char* Vt = L + OFF_VT + buf * VT_BYTES;
        const size_t qrow = qrow0 + (size_t)n * 128;
        u32x2 sgv[8];
        u32x4 sgraw[2][2];
#pragma unroll
        for (int eb = 0; eb < 2; ++eb)
#pragma unroll
            for (int gp = 0; gp < 2; ++gp) sgraw[eb][gp] = *(const u32x4*)(SG + (hmbase + (size_t)n * 128 + 32 * rb + r32) * 128 + 64 * eh + 32 * eb + 8 * (2 * hi + gp));
        bf16x8 qf[4];
#pragma unroll
        for (int ks = 0; ks < 4; ++ks) qf[ks] = *(const LAS bf16x8*)(L + OFF_Q + (32 * rb + r32) * SB_PITCH + (16 * ks + 8 * hi) * 2);
        const int nn = n < 15 ? n + 1 : 15;
        RET_LOAD(nn);
        f32x16 y0 = {}, y1 = {};
#pragma unroll
        for (int kb = 0; kb < 4; ++kb) if (kb <= rb) {
            bf16x8 ka[4];
#pragma unroll
            for (int ks = 0; ks < 4; ++ks) ka[ks] = *(const LAS bf16x8*)(Kt + ks * RSTR + (32 * kb + r32) * 32 + hi * 16);
            s16x4 vl0[2][2], vh0[2][2];
#pragma unroll
            for (int s = 0; s < 2; ++s)
#pragma unroll
                for (int eb = 0; eb < 2; ++eb) { const LAS unsigned char* vp = Vt + (4 * eh + 2 * eb + g16) * RSTR + (32 * kb + 16 * s) * 32 + troff; vl0[s][eb] = vtr(vp); vh0[s][eb] = vtr(vp + 8 * 32); }
            __builtin_amdgcn_sched_barrier(0);
            f32x16 in = {};
#pragma unroll
            for (int ks = 0; ks < 4; ++ks) in = __builtin_amdgcn_mfma_f32_32x32x16_bf16(ka[ks], qf[ks], in, 0, 0, 0);
            if (kb == rb) {
#pragma unroll
                for (int r = 0; r < 16; ++r) if (crow(r, hi) > r32) in[r] = 0.f; }
#pragma unroll
            for (int s = 0; s < 2; ++s) { u32x4 pw; pw.x = cvt_pk_bf16(in[8 * s], in[8 * s + 1]); pw.y = cvt_pk_bf16(in[8 * s + 2], in[8 * s + 3]); pw.z = cvt_pk_bf16(in[8 * s + 4], in[8 * s + 5]); pw.w = cvt_pk_bf16(in[8 * s + 6], in[8 * s + 7]);
                const bf16x8 pf = __builtin_bit_cast(bf16x8, pw);
                y0 = __builtin_amdgcn_mfma_f32_32x32x16_bf16(RET_PK(vl0[s][0], vh0[s][0]), pf, y0, 0, 0, 0);
                y1 = __builtin_amdgcn_mfma_f32_32x32x16_bf16(RET_PK(vl0[s][1], vh0[s][1]), pf, y1, 0, 0, 0); }
            __builtin_amdgcn_sched_barrier(0);
        }
        { bf16x8 sa[2][4];
#pragma unroll
          for (int eb = 0; eb < 2; ++eb)
#pragma unroll
              for (int ks = 0; ks < 4; ++ks) sa[eb][ks] = *(const LAS bf16x8*)(L + OFF_SB + (64 * eh + 32 * eb + r32) * SB_PITCH + (16 * ks + 8 * hi) * 2);
          __builtin_amdgcn_sched_barrier(0);
#pragma unroll
          for (int ks = 0; ks < 4; ++ks) { y0 = __builtin_amdgcn_mfma_f32_32x32x16_bf16(sa[0][ks], qf[ks], y0, 0, 0, 0); y1 = __builtin_amdgcn_mfma_f32_32x32x16_bf16(sa[1][ks], qf[ks], y1, 0, 0, 0); }
          __builtin_amdgcn_sched_barrier(0); }
        { float ss = 0.f;
#pragma unroll
          for (int r = 0; r < 16; ++r) ss += y0[r] * y0[r] + y1[r] * y1[r];
          auto rr = __builtin_amdgcn_permlane32_swap(__float_as_uint(ss), __float_as_uint(ss), false, false); ss = __uint_as_float(rr[0]) + __uint_as_float(rr[1]);
          if (hi == 0) ((LAS float*)(L + OFF_X))[(32 * rb + r32) * 2 + eh] = ss; }
        f32x16 U = {};
#pragma unroll
        for (int s2 = 0; s2 < 4; ++s2) {
            s16x4 al[2], ah[2], bl[2], bh_[2];
#pragma unroll
            for (int q = 0; q < 2; ++q) { const int s = 2 * s2 + q; const LAS unsigned char* ap = Vt + (2 * (w >> 1) + g16) * RSTR + (16 * s) * 32 + troff; const LAS unsigned char* bp = Kt + (2 * (w & 1) + g16) * RSTR + (16 * s) * 32 + troff;
                al[q] = vtr(ap); ah[q] = vtr(ap + 8 * 32); bl[q] = vtr(bp); bh_[q] = vtr(bp + 8 * 32); }
            __builtin_amdgcn_sched_barrier(0);
#pragma unroll
            for (int q = 0; q < 2; ++q) U = __builtin_amdgcn_mfma_f32_32x32x16_bf16(RET_PK(al[q], ah[q]), RET_PK(bl[q], bh_[q]), U, 0, 0, 0);
            __builtin_amdgcn_sched_barrier(0);
        }
        RET_BAR();
        RET_WRITE(buf ^ 1);
        { const float tot = ((const LAS float*)(L + OFF_X))[(32 * rb + r32) * 2] + ((const LAS float*)(L + OFF_X))[(32 * rb + r32) * 2 + 1];
          const float rs = 1.0f / sqrtf(tot * (1.f / 128.f) + EPS);
#pragma unroll
          for (int eb = 0; eb < 2; ++eb)
#pragma unroll
              for (int gp = 0; gp < 2; ++gp) { const u32x4 rw = sgraw[eb][gp];
                  const auto sx = __builtin_amdgcn_permlane32_swap(rw.x, rw.z, false, false), sy = __builtin_amdgcn_permlane32_swap(rw.y, rw.w, false, false);
                  u32x2 own, rcv; own.x = hi ? rw.z : rw.x; own.y = hi ? rw.w : rw.y; rcv.x = hi ? sx[0] : sx[1]; rcv.y = hi ? sy[0] : sy[1];
                  sgv[eb * 4 + gp] = hi ? rcv : own; sgv[eb * 4 + 2 + gp] = hi ? own : rcv; }
          u32x2 ypk[8];
#pragma unroll
          for (int q = 0; q < 8; ++q) { const int eb = q >> 2, g = q & 3, e0 = 64 * eh + 32 * eb + 8 * g + 4 * hi; const u32x2 sg = sgv[q];
              const f32x4 gv = *(const LAS f32x4*)(L + OFF_G + e0 * 4);
              float o0, o1, o2, o3;
              if (eb == 0) { o0 = y0[4 * g]; o1 = y0[4 * g + 1]; o2 = y0[4 * g + 2]; o3 = y0[4 * g + 3]; } else { o0 = y1[4 * g]; o1 = y1[4 * g + 1]; o2 = y1[4 * g + 2]; o3 = y1[4 * g + 3]; }
              u32x2 wv; wv.x = cvt_pk_bf16(o0 * gv[0] * rs * __builtin_bit_cast(float, sg.x << 16), o1 * gv[1] * rs * __builtin_bit_cast(float, sg.x & 0xffff0000u));
              wv.y = cvt_pk_bf16(o2 * gv[2] * rs * __builtin_bit_cast(float, sg.y << 16), o3 * gv[3] * rs * __builtin_bit_cast(float, sg.y & 0xffff0000u));
              ypk[q] = wv; }
#pragma unroll
          for (int eb = 0; eb < 2; ++eb)
#pragma unroll
              for (int gp = 0; gp < 2; ++gp) { const u32x2 a = ypk[eb * 4 + gp], b = ypk[eb * 4 + 2 + gp];
                  const auto sx = __builtin_amdgcn_permlane32_swap(a.x, b.x, false, false), sy = __builtin_amdgcn_permlane32_swap(a.y, b.y, false, false);
                  u32x4 st; if (hi) { st.x = sx[0]; st.y = sy[0]; st.z = b.x; st.w = b.y; } else { st.x = a.x; st.y = a.y; st.z = sx[1]; st.w = sy[1]; }
                  *(u32x4*)(Y + qrow * 1024 + h * 128 + 64 * eh + 32 * eb + 8 * (2 * hi + gp)) = st; } }
#pragma unroll
        for (int r = 0; r < 16; ++r) { S[r] = S[r] * gC + U[r] * gC1;
            *(LAS bf16_t*)(L + OFF_SB + (32 * (w >> 1) + crow(r, hi)) * SB_PITCH + (32 * (w & 1) + r32) * 2) = f2bf(S[r] * gmm); }
        RET_BAR();
    }
#undef RET_LOAD
#undef RET_WRITE
}
}

constexpr int RING_OFF = 0, RING_BYTES = 131072;
constexpr int LDSCTL_OFF = RING_BYTES, MISC_OFF = LDSCTL_OFF + 320;
constexpr int EPI_OFF = RING_BYTES + 1024;
constexpr int LDS_BYTES = 160 * 1024;
constexpr int NWAVES = 8;
constexpr int CW_TMO = 0, CW_CODE = 1, CW_BAR = 4096, CW_ATT = 49152;
constexpr int MAX_BAR_REGIONS = 8;
static_assert(CW_BAR + MAX_BAR_REGIONS * XCD_BAR_WORDS <= CW_ATT && (CW_ATT + MAX_BAR_REGIONS * 8 * 64) * 4 <= (int)CTL_ZERO_BYTES, "CTL words inside the memset region");

struct Args { const float* in[18]; float* out; unsigned char* ws; int ph_lo, ph_hi, li, pad; };

__global__ void __launch_bounds__(NWAVES * 64, 2) mk_fwd(Args args) {
    extern __shared__ __attribute__((aligned(16))) unsigned char lds_raw[];
    LAS unsigned char* lds = (LAS unsigned char*)lds_raw;
    volatile LAS unsigned* MISC = (volatile LAS unsigned*)(lds + MISC_OFF);
    const int wave = __builtin_amdgcn_readfirstlane((int)threadIdx.x >> 6);
#define FRESH_LANE() ({ int l_; asm volatile("v_mbcnt_lo_u32_b32 %0, -1, 0\n\tv_mbcnt_hi_u32_b32 %0, -1, %0" : "=v"(l_)); l_; })
    const int G = gridDim.x;
    unsigned char* ws = args.ws;
    gu32* ctl = (gu32*)(ws + WS_CTL);
    for (int u = (int)threadIdx.x; u < 1024 / 4; u += NWAVES * 64) ((LAS unsigned*)(lds + LDSCTL_OFF))[u] = 0u;
    __syncthreads();
    XcdBarrier bar = xcd_barrier_post((unsigned*)(ctl + CW_BAR) + args.li * XCD_BAR_WORDS, MISC + 8, threadIdx.x == 0);
    const int lo = args.ph_lo, hi = args.ph_hi;
#ifndef PHASE_MASK
#define PHASE_MASK 0x1ff
#endif
#define IN(k) (((PHASE_MASK >> (k)) & 1) && lo <= (k) && (k) < hi)
#define BOTH(k) (IN(k) && IN((k) + 1))
    float* out = args.out;
    const float* x = args.in[0];

#ifdef VPROBE
    {
        typedef float f2_ __attribute__((ext_vector_type(2)));
        f2_ r[16]; const float kk = 1.0000001f; const f2_ k2 = {kk, kk};
#pragma unroll
        for (int j = 0; j < 16; ++j) { r[j][0] = (float)(threadIdx.x + j); r[j][1] = (float)(threadIdx.x + 2 * j); }
        for (int it = 0; it < 20000; ++it) {
#pragma unroll
            for (int j = 0; j < 16; ++j) {
#if VPROBE == 1
                asm volatile("v_pk_mul_f32 %0, %0, %1" : "+v"(r[j]) : "v"(k2));
#elif VPROBE == 2
                asm volatile("v_mul_f32 %0, %0, %1" : "+v"(r[j][0]) : "v"(kk)); asm volatile("v_mul_f32 %0, %0, %1" : "+v"(r[j][1]) : "v"(kk));
#elif VPROBE == 3
                asm volatile("v_pk_fma_f32 %0, %0, %1, %1" : "+v"(r[j]) : "v"(k2));
#elif VPROBE == 4
                asm volatile("v_exp_f32 %0, %0" : "+v"(r[j][0])); asm volatile("v_rcp_f32 %0, %0" : "+v"(r[j][1]));
#endif
            }
        }
        float s = 0.f;
#pragma unroll
        for (int j = 0; j < 16; ++j) s += r[j][0] + r[j][1];
        if (s == 12345.678f) args.out[0] = s;
    }
#endif
    if (IN(0)) {
        const int lane = FRESH_LANE(), tid = wave * 64 + lane;
        LAS float* scr = (LAS float*)(lds + RING_OFF + wave * 16384);
        const int gw = (int)blockIdx.x * NWAVES + wave, NGW = G * NWAVES;
        constexpr int I1 = (DM / 64) * (DIN / 32), IA = (512 / 64) * (DM / 32), IB = (DM / 64) * (DM / 32), IO = IB, I2 = (DM / 64) * (2 * DFF / 32), I3 = (DFF / 64) * (DM / 32), IG = IB, IP = (PLE / 64) * (DM / 32);
        constexpr int NITEMS = I1 + IA + IB + IO + I2 + I3 + IG + IP;
        for (int it = gw; it < NITEMS; it += NGW) {
            int r = it;
            if (r < I1) { p0_transpose_item(args.in[3], args.in[2], DM, DIN, (bf16_t*)(ws + WS_W1), DM, 1, scr, r, lane); continue; } r -= I1;
            if (r < IA) { p0_transpose_item(args.in[7], nullptr, 512, DM, (bf16_t*)(ws + WS_WAB), 1536, 0, scr, r, lane); continue; } r -= IA;
            if (r < IB) { p0_transpose_item(args.in[8], nullptr, DM, DM, (bf16_t*)(ws + WS_WAB) + 512, 1536, 0, scr, r, lane); continue; } r -= IB;
            if (r < IO) { p0_transpose_item(args.in[9], nullptr, DM, DM, (bf16_t*)(ws + WS_WO), DM, 0, scr, r, lane); continue; } r -= IO;
            if (r < I2) { p0_transpose_item(args.in[11], args.in[10], DM, 2 * DFF, (bf16_t*)(ws + WS_W2), DM, 2, scr, r, lane); continue; } r -= I2;
            if (r < I3) { p0_transpose_item(args.in[14], nullptr, DFF, DM, (bf16_t*)(ws + WS_W3), DFF, 0, scr, r, lane); continue; } r -= I3;
            if (r < IG) { p0_transpose_item(args.in[16], args.in[15], DM, DM, (bf16_t*)(ws + WS_WPG), DM, 0, scr, r, lane); continue; } r -= IG;
            p0_transpose_item(args.in[17], nullptr, PLE, DM, (bf16_t*)(ws + WS_WPP), PLE, 0, scr, r, lane);
        }
        for (int m0 = gw * 4; m0 < M; m0 += NGW * 4) {
            f32x4 v[4][4];
#pragma unroll
            for (int r = 0; r < 4; ++r) { const f32x4* xr = (const f32x4*)(x + (size_t)(m0 + r) * DM) + lane;
#pragma unroll
                for (int j = 0; j < 4; ++j) v[r][j] = __builtin_nontemporal_load(xr + 64 * j); }
#pragma unroll
            for (int r = 0; r < 4; ++r) { float ss = 0.f;
#pragma unroll
                for (int j = 0; j < 4; ++j) ss += (v[r][j][0] * v[r][j][0] + v[r][j][1] * v[r][j][1]) + (v[r][j][2] * v[r][j][2] + v[r][j][3] * v[r][j][3]);
                ss = wave_sum(ss);
                if (lane == 0) ((float*)(ws + WS_RSTD0))[m0 + r] = 1.0f / sqrtf(ss * (1.f / DM) + EPS);
                bf16_t* orow = (bf16_t*)out + (size_t)(m0 + r) * DM + (size_t)((m0 + r) >> 12) * GSKIP_EL; const bool odd = lane & 1;
#pragma unroll
                for (int jp = 0; jp < 2; ++jp) { u32x2 wa, wb; wa.x = pk2(v[r][2 * jp][0], v[r][2 * jp][1]); wa.y = pk2(v[r][2 * jp][2], v[r][2 * jp][3]); wb.x = pk2(v[r][2 * jp + 1][0], v[r][2 * jp + 1][1]); wb.y = pk2(v[r][2 * jp + 1][2], v[r][2 * jp + 1][3]);
                    const unsigned rx = p0_swap1(odd ? wa.x : wb.x), ry = p0_swap1(odd ? wa.y : wb.y);
                    u32x4 st; if (odd) { st.x = rx; st.y = ry; st.z = wb.x; st.w = wb.y; } else { st.x = wa.x; st.y = wa.y; st.z = rx; st.w = ry; }
                    *(u32x4*)(orow + 256 * (2 * jp + (odd ? 1 : 0)) + 4 * (lane & ~1)) = st; } }
        }
        { const f32x4* p4 = (const f32x4*)args.in[1]; u32x2* o = (u32x2*)(ws + WS_PB);
          const int T = G * NWAVES * 64;
          for (int i = (int)blockIdx.x * (NWAVES * 64) + tid; i < M * PLE / 4; i += 4 * T) { f32x4 v[4];
#pragma unroll
              for (int q = 0; q < 4; ++q) v[q] = __builtin_nontemporal_load(p4 + i + q * T);
#pragma unroll
              for (int qp = 0; qp < 2; ++qp) { const bool odd = tid & 1; u32x2 wa, wb; wa.x = pk2(v[2 * qp][0], v[2 * qp][1]); wa.y = pk2(v[2 * qp][2], v[2 * qp][3]); wb.x = pk2(v[2 * qp + 1][0], v[2 * qp + 1][1]); wb.y = pk2(v[2 * qp + 1][2], v[2 * qp + 1][3]);
                  const unsigned rx = p0_swap1(odd ? wa.x : wb.x), ry = p0_swap1(odd ? wa.y : wb.y);
                  u32x4 st; if (odd) { st.x = rx; st.y = ry; st.z = wb.x; st.w = wb.y; } else { st.x = wa.x; st.y = wa.y; st.z = rx; st.w = ry; }
                  *(u32x4*)(o + (i & ~1) + (2 * qp + (odd ? 1 : 0)) * T) = st; } } }
        { float* rope = (float*)(ws + WS_ROPE);
          for (int i = (int)blockIdx.x * (NWAVES * 64) + tid; i < SEQ * 32; i += G * NWAVES * 64) { const int t = i >> 5, j = i & 31;
              const float inv = powf(10000.f, -(float)j * (2.0f / 64.f)); float sn, cs; sincosf((float)t * inv, &sn, &cs); rope[i] = cs; rope[SEQ * 32 + i] = sn; } }
        if (BOTH(0)) xcd_barrier(bar, wave);
    }
    int vb = (int)blockIdx.x; bool fastp = false;
    if (lo == 0 && BOTH(0)) { const unsigned reg_ = MISC[10], rk_ = MISC[11]; fastp = __builtin_amdgcn_readfirstlane((int)reg_) == 1; if (fastp) vb = __builtin_amdgcn_readfirstlane((int)rk_) * 8 + (int)bar.x; }
    if (IN(1)) {
        { pg8::Gemm g{(const bf16_t*)out  , (const bf16_t*)(ws + WS_W1), M, 26 * 256, DM}; g.pad2 = (int)GSKIP_EL;
          pg8::CatOrder S; S.a.init(M, 8 * 256, G, vb); S.a.ntk = DM / 64; S.b.init(M, 18 * 256, G, vb); S.b.ntk = DM / 64; S.na = (M / 256) * 8 / G; S.pnoff = 18;
          pg8::EpProj E{0, 0, (const float*)(ws + WS_RSTD0), ws, args.in[4], args.in[5], (const float*)(ws + WS_ROPE)};
          pg8::gemm_phase<pg8::EpProj, pg8::CatOrder, true, true>(lds + RING_OFF, g, S, E, wave); }
        if (BOTH(1)) xcd_barrier(bar, wave, fastp);
    }
    if (IN(2)) {
        const bf16_t* Q = (const bf16_t*)(ws + WS_QSB); const bf16_t* Kk = (const bf16_t*)(ws + WS_KSB); const bf16_t* V = (const bf16_t*)(ws + WS_VSB);
        bf16_t* Ysb = (bf16_t*)(ws + WS_QSB);
        bf16_t* Yr = (bf16_t*)out + GSKIP_EL;
        if (((vb >> 3) & 1) == 0 && !(args.pad & 4)) {
            const int j_ = vb >> 4; const int bh = (2 * (vb & 7) + (j_ >> 3)) * 8 + (j_ & 7);
            if (bh < NB * 8) ret::ret_seq(bh, (const bf16_t*)(ws + WS_QR) + (size_t)(bh >> 4) * GSK_4, (const bf16_t*)(ws + WS_KR) + (size_t)(bh >> 4) * GSK_4, (const bf16_t*)(ws + WS_VR) + (size_t)(bh >> 4) * GSK_8, (const bf16_t*)(ws + WS_SGR) + (size_t)(bh >> 4) * GSK_8, args.in[6], Yr + (size_t)(bh >> 4) * GSKIP_EL, lds + RING_OFF, wave * 64 + FRESH_LANE());
        }
        if (!(args.pad & 8)) {
            const int lane = FRESH_LANE();
            LAS unsigned char* vl = lds + RING_OFF + wave * sba::WAVE_LDS;
            const int shard = vb & 7; gu32* ctr = ctl + CW_ATT + (args.li * 8 + shard) * 64;
            for (;;) {
                int it2 = 0; if (lane == 0) it2 = (int)__hip_atomic_fetch_add(ctr, 1u, __ATOMIC_RELAXED, __HIP_MEMORY_SCOPE_AGENT);
                it2 = __builtin_amdgcn_readfirstlane(it2);
                if (it2 >= 1024) break;
                sba::attn_item(shard * 1024 + it2, Q, Kk, V, Ysb, vl, lane);
            }
            __syncthreads();
        }
        if (BOTH(2)) xcd_barrier(bar, wave, fastp);
    }
    if (IN(3)) {
        pg8::Gemm g{(const bf16_t*)out + GSKIP_EL  , (const bf16_t*)(ws + WS_WAB), M, DM, 1536, DM, (const bf16_t*)(ws + WS_QSB)  , 512, (int)GSKIP_EL}; pg8::PairOrder S; S.base.init(M, DM, G, vb); S.base.ntk = 0;
        pg8::EpMerged E{0, 0, (const bf16_t*)(ws + WS_SA), (bf16_t*)(ws + WS_SB)};
        pg8::gemm_phase<pg8::EpMerged, pg8::PairOrder, true, true, true>(lds + RING_OFF, g, S, E, wave);
        if (BOTH(3)) xcd_barrier(bar, wave, fastp);
    }
    if (IN(4)) {
        if (!(args.pad & 2)) { pg8::Gemm g{(const bf16_t*)(ws + WS_MERGED), (const bf16_t*)(ws + WS_WO), M, DM, DM}; pg8::StaticOrder S; S.init(M, DM, G, vb); S.ntk = DM / 64;
          pg8::EpResid<true> E{(int)GSKIP_EL, (int)GSK_8, (const void*)out  , (bf16_t*)(ws + WS_X1B), (float*)(ws + WS_PART1)};
          pg8::gemm_phase<pg8::EpResid<true>, pg8::StaticOrder, true, true>(lds + RING_OFF, g, S, E, wave); }
        if (BOTH(4)) xcd_barrier(bar, wave, fastp);
    }
    if (IN(5)) {
        pg8::Gemm g{(const bf16_t*)(ws + WS_X1B), (const bf16_t*)(ws + WS_W2), M, 2 * DFF, DM}; g.pad2 = (int)GSK_8; pg8::StaticOrder S; S.init(M, 2 * DFF, G, vb); S.ntk = DM / 64;
        pg8::Unit u0; (void)S.next(0, u0);
        {
            const int tid = wave * 64 + FRESH_LANE(); LAS float* tab = (LAS float*)(lds + EPI_OFF + 4096); pg8::Unit fu; int prev_pm = -1, slot = 0;
            for (int i = 0; S.next(i, fu); ++i) { if (fu.pm == prev_pm) continue; prev_pm = fu.pm; slot = (fu.pm - u0.pm) / pg8::WGM;
                if (tid < 256 && slot < 8) tab[slot * 256 + tid] = rstd_part((const float*)(ws + WS_PART1), fu.pm * 256 + tid); }
            __syncthreads();
        }
        pg8::EpUp E{u0.pm, pg8::WGM, (const float*)(ws + WS_PART1), args.in[12], args.in[13], (bf16_t*)(ws + WS_ACT), (float*)(ws + WS_HALO)};
        pg8::gemm_phase<pg8::EpUp, pg8::StaticOrder, true, true>(lds + RING_OFF, g, S, E, wave);
        if (BOTH(5)) xcd_barrier(bar, wave, fastp);
    }
    if (IN(7)) {
        pg8::Gemm g{(const bf16_t*)(ws + WS_ACT), (const bf16_t*)(ws + WS_W3), M, DM, DFF}; g.pad2 = (int)GSK_ACT; pg8::StaticOrder S; S.init(M, DM, G, vb); S.ntk = DFF / 64; S.rev = 1;
        {   const int tid = wave * 64 + FRESH_LANE();
            const float* halo = (const float*)(ws + WS_HALO); const float* cw = args.in[12]; const float* cb = args.in[13]; bf16_t* act = (bf16_t*)(ws + WS_ACT);
            pg8::Unit fu; int pms[2] = {-1, -1}; int npm = 0;
            for (int i = 0; S.next(i, fu); ++i) { if (npm > 0 && fu.pm == pms[npm - 1]) continue; if (npm < 2) pms[npm++] = fu.pm; }
            constexpr int C4 = DFF / 4;
            const int nitems = npm * 2 * C4;
#pragma unroll 1
            for (int base = tid; base < nitems; base += 2 * NWAVES * 64) {
                f32x4 a0v[2], u0v[2], l0v[2], l1v[2], f0v[2], w0v[2], w1v[2], w2v[2], bbv[2]; int pmv[2], jv[2], chv[2]; bool ok[2];
#pragma unroll
                for (int q = 0; q < 2; ++q) { const int idx = base + q * NWAVES * 64; ok[q] = idx < nitems; const int id = ok[q] ? idx : 0;
                    const int slot = id / (2 * C4), rem = id % (2 * C4), j = rem / C4, ch = 4 * (rem % C4), pm = slot ? pms[1] : pms[0]; pmv[q] = pm; jv[q] = j; chv[q] = ch;
                    const int pmp = (pm & 7) ? pm - 1 : pm;
                    a0v[q] = *(const f32x4*)(halo + HALO_ELEMS + ((size_t)pm * 2 + j) * DFF + ch); u0v[q] = *(const f32x4*)(halo + 2 * HALO_ELEMS + ((size_t)pm * 2 + j) * DFF + ch);
                    f0v[q] = *(const f32x4*)(halo + HALO_ELEMS + ((size_t)pm * 2) * DFF + ch);
                    l0v[q] = *(const f32x4*)(halo + ((size_t)pmp * 2) * DFF + ch); l1v[q] = *(const f32x4*)(halo + ((size_t)pmp * 2 + 1) * DFF + ch);
                    w0v[q] = *(const f32x4*)(cw + ch); w1v[q] = *(const f32x4*)(cw + DFF + ch); w2v[q] = *(const f32x4*)(cw + 2 * DFF + ch); bbv[q] = *(const f32x4*)(cb + ch); }
#pragma unroll
                for (int q = 0; q < 2; ++q) if (ok[q]) { const bool first = (pmv[q] & 7) == 0; const f32x4 z = {0.f, 0.f, 0.f, 0.f};
                    const f32x4 L0 = first ? z : l0v[q], L1 = first ? z : l1v[q];
                    const f32x4 p1 = jv[q] ? f0v[q] : L1, p2 = jv[q] ? L1 : L0;
                    const f32x4 c = bbv[q] + w0v[q] * p2 + w1v[q] * p1 + w2v[q] * a0v[q];
                    u32x2 w; w.x = cvt_pk_bf16(fast_gelu(c[0]) * u0v[q][0], fast_gelu(c[1]) * u0v[q][1]); w.y = cvt_pk_bf16(fast_gelu(c[2]) * u0v[q][2], fast_gelu(c[3]) * u0v[q][3]);
                    *(u32x2*)(act + (size_t)(pmv[q] >> 4) * GSK_ACT + ((size_t)pmv[q] * 256 + jv[q]) * DFF + chv[q]) = w; }
            }
            asm volatile("s_waitcnt vmcnt(0)" ::: "memory"); __syncthreads();
        }
        pg8::EpResid<true> E{(int)GSK_8, 0, (const void*)(ws + WS_X1B), (bf16_t*)(ws + WS_X2B), (float*)(ws + WS_PART2)};
        pg8::gemm_phase<pg8::EpResid<true>, pg8::StaticOrder, true, true>(lds + RING_OFF, g, S, E, wave);
        {
            pg8::Gemm gp{(const bf16_t*)(ws + WS_PB), (const bf16_t*)(ws + WS_WPP), M, DM, PLE}; pg8::StaticOrder Sp; Sp.init(M, DM, G, vb); Sp.ntk = PLE / 64;
            pg8::EpStore Ep{0, DM, (bf16_t*)(ws + WS_PP2)};
            pg8::gemm_phase<pg8::EpStore, pg8::StaticOrder, true, true>(lds + RING_OFF, gp, Sp, Ep, wave); }
        if (BOTH(7)) xcd_barrier(bar, wave, fastp);
    }
    if (IN(8)) {
        pg8::Gemm g{(const bf16_t*)(ws + WS_X2B), (const bf16_t*)(ws + WS_WPG), M, DM, DM}; pg8::StaticOrder S; S.init(M, DM, G, vb); S.ntk = DM / 64;
        pg8::Unit u0; (void)S.next(0, u0);
        {
            const int tid = wave * 64 + FRESH_LANE(); LAS float* tab = (LAS float*)(lds + EPI_OFF + 4096); pg8::Unit fu; int prev_pm = -1;
            for (int i = 0; S.next(i, fu); ++i) { if (fu.pm == prev_pm) continue; prev_pm = fu.pm; const int slot = (fu.pm - u0.pm) / pg8::WGM;
                if (tid < 256 && slot < 8) tab[slot * 256 + tid] = rstd_part((const float*)(ws + WS_PART2), fu.pm * 256 + tid); }
            __syncthreads();
        }
        pg8::EpFinalP E{u0.pm, pg8::WGM, (const float*)(ws + WS_PART2), (const bf16_t*)(ws + WS_PP2), (const bf16_t*)(ws + WS_X2B), out};
        pg8::gemm_phase<pg8::EpFinalP, pg8::StaticOrder, true, true>(lds + RING_OFF, g, S, E, wave);
    }
#undef IN
#undef BOTH
}

extern "C" void kernel_launch(void* const* d_in, const int* in_sizes, int n_in, void* d_out, int out_size, void* d_ws, size_t ws_size, hipStream_t stream) {
    static int grid = 0;
    if (grid == 0) {
        if (n_in != 18 || out_size != M * DM || ws_size < WS_END) { fprintf(stderr, "kernel_launch: unexpected sizes n_in %d out %d ws %zu\n", n_in, out_size, ws_size); grid = -1; return; }
        int dev = 0, cus = 0;
        if (hipGetDevice(&dev) != hipSuccess || hipDeviceGetAttribute(&cus, hipDeviceAttributeMultiprocessorCount, dev) != hipSuccess) { grid = -1; return; }
        if (hipFuncSetAttribute((const void*)mk_fwd, hipFuncAttributeMaxDynamicSharedMemorySize, LDS_BYTES) != hipSuccess) { fprintf(stderr, "kernel_launch: hipFuncSetAttribute failed\n"); grid = -1; return; }
        (void)hipGetLastError();
        grid = cus;
    }
    if (grid < 0) return;
    unsigned char* ws = (unsigned char*)d_ws; float* out = (float*)d_out;
    (void)hipMemsetAsync((char*)d_ws + WS_CTL, 0, CTL_ZERO_BYTES, stream);
    Args a{}; for (int i = 0; i < 18; ++i) a.in[i] = (const float*)d_in[i]; a.out = out; a.ws = ws;
    int li = 0;
#define MKF(lo_, hi_, fl_) do { a.ph_lo = (lo_); a.ph_hi = (hi_); a.pad = (fl_); a.li = li++; hipLaunchKernelGGL(mk_fwd, dim3(grid), dim3(NWAVES * 64), LDS_BYTES, stream, a); } while (0)
#define MK(lo_, hi_) MKF(lo_, hi_, 1)
#ifndef PROBE_PHASE
#define PROBE_PHASE -1
#endif
#ifndef PROBE_FLAGS
#define PROBE_FLAGS 1
#endif
    if (PROBE_PHASE < 0) MK(0, 9);
    else { MK(0, PROBE_PHASE + 1); MKF(PROBE_PHASE, PROBE_PHASE + 1, PROBE_FLAGS); if (PROBE_PHASE + 1 < 9) MK(PROBE_PHASE + 1, 9); }
}
```
